# Optimizing an MI355X kernel written in HIP

```python
import jax, jax.numpy as jnp
from jax import lax
import numpy as np

D_MODEL = 2048
BATCH = 4
SEQ = 8192
DEPTH = 1

HEAD_DIM = 128
NSA_HEADS = D_MODEL // (2 * HEAD_DIM)
NSA_KV_HEADS = 2
NSA_GROUP = NSA_HEADS // NSA_KV_HEADS
NSA_WIDTH = NSA_HEADS * HEAD_DIM
KV_WIDTH = NSA_KV_HEADS * HEAD_DIM
CMP_BLOCK = 32
CMP_STRIDE = 16
CMP_HIDDEN = 256
SEL_BLOCK = 64
SEL_TOPK = 16
SEL_LOCAL = 2
WINDOW = 512
Q_BLOCK = 128
GLA_HEADS = 4
GLA_DV = D_MODEL // (2 * GLA_HEADS)
GLA_DK = GLA_DV // 2
GLA_WIDTH = GLA_HEADS * GLA_DV
GLA_GATE_RANK = 16
GLA_GATE_TAU = 16.0
GLA_CHUNK = 64
MIX_WIDTH = NSA_WIDTH + GLA_WIDTH
N_EXPERTS = 32
TOP_K = 4
D_FF = D_MODEL
SWIGLU_LIMIT = 7.0
SWIGLU_ALPHA = 1.702
MOE_BLOCK = 256
LN_EPS = 1e-5
RMS_EPS = 1e-6
NEG_INF = -1e30
FORCE_SCORE = 1e6
DN_ALPHA = (2 * DEPTH) ** 0.25
DN_BETA = (8 * DEPTH) ** -0.25
PROJ_WIDTHS = (NSA_WIDTH, KV_WIDTH, KV_WIDTH, KV_WIDTH, KV_WIDTH, KV_WIDTH, KV_WIDTH, 3 * NSA_HEADS,
               GLA_HEADS * GLA_DK, GLA_HEADS * GLA_DK, GLA_WIDTH, GLA_GATE_RANK, GLA_WIDTH)
IN_WIDTH = sum(PROJ_WIDTHS)
VALUE_SEGMENTS = (2, 4, 6, 10)

kernel_name = "hybrid_nsa_gla_moe_block"


def split_cols(p):
    outs = []
    off = 0
    for w in PROJ_WIDTHS:
        outs.append(p[..., off:off + w])
        off += w
    return outs


def layer_norm(x, g, b):
    xf = x.astype(jnp.float32)
    mu = jnp.mean(xf, axis=-1, keepdims=True)
    var = jnp.mean(jnp.square(xf - mu), axis=-1, keepdims=True)
    return ((xf - mu) * lax.rsqrt(var + LN_EPS) * g + b).astype(x.dtype)


def alibi_slopes(n):
    return 2.0 ** (-8.0 * jnp.arange(1, n + 1, dtype=jnp.float32) / n)


def compress_tokens(kv, pe, w1, b1, w2):
    bsz, seq = kv.shape[:2]
    n_cmp = (seq - CMP_BLOCK) // CMP_STRIDE + 1
    idx = jnp.arange(n_cmp)[:, None] * CMP_STRIDE + jnp.arange(CMP_BLOCK)[None, :]
    blocks = kv[:, idx] + pe[None, None, :, None, :]
    flat = blocks.transpose(0, 1, 3, 2, 4).reshape(bsz, n_cmp, NSA_KV_HEADS, CMP_BLOCK * HEAD_DIM)
    return jax.nn.gelu(flat @ w1 + b1) @ w2


def nsa_attention(q, k_cmp, v_cmp, k_sel, v_sel, k_win, v_win, gates,
                  pe_k, w1_k, b1_k, w2_k, pe_v, w1_v, b1_v, w2_v):
    bsz, seq = q.shape[:2]
    G, R, Dh = NSA_KV_HEADS, NSA_GROUP, HEAD_DIM
    scale = Dh ** -0.5
    slopes = alibi_slopes(NSA_HEADS).reshape(G, R)
    kc = compress_tokens(k_cmp, pe_k, w1_k, b1_k, w2_k)
    vc = compress_tokens(v_cmp, pe_v, w1_v, b1_v, w2_v)
    n_cmp = kc.shape[1]
    cmp_start = jnp.arange(n_cmp) * CMP_STRIDE
    cmp_end = cmp_start + CMP_BLOCK - 1
    cmp_mid = cmp_start.astype(jnp.float32) + (CMP_BLOCK - 1) / 2.0
    n_sel = seq // SEL_BLOCK
    n_topk = min(SEL_TOPK, n_sel)
    sel_start = jnp.arange(n_sel) * SEL_BLOCK
    overlap = ((cmp_start[:, None] < sel_start[None, :] + SEL_BLOCK) &
               (cmp_start[:, None] + CMP_BLOCK > sel_start[None, :])).astype(jnp.float32)
    kb = k_sel.reshape(bsz, n_sel, SEL_BLOCK, G, Dh).transpose(0, 3, 1, 2, 4)
    vb = v_sel.reshape(bsz, n_sel, SEL_BLOCK, G, Dh).transpose(0, 3, 1, 2, 4)
    kw = jnp.pad(k_win, ((0, 0), (WINDOW, 0), (0, 0), (0, 0)))
    vw = jnp.pad(v_win, ((0, 0), (WINDOW, 0), (0, 0), (0, 0)))
    qg = q.reshape(bsz, seq, G, R, Dh)
    gg = gates.reshape(bsz, seq, G, R, 3)
    gather_blocks = jax.vmap(jax.vmap(lambda tbl, ix: tbl[ix]))

    def query_block(i):
        q0 = i * Q_BLOCK
        qb = lax.dynamic_slice_in_dim(qg, q0, Q_BLOCK, axis=1) * scale
        gb = lax.dynamic_slice_in_dim(gg, q0, Q_BLOCK, axis=1)
        pos = q0 + jnp.arange(Q_BLOCK)
        posf = pos.astype(jnp.float32)
        s = jnp.einsum('bqgrd,bcgd->bgrqc', qb, kc).astype(jnp.float32)
        s = s - slopes[None, :, :, None, None] * jnp.abs(posf[:, None] - cmp_mid[None, :])
        ok = cmp_end[None, :] <= pos[:, None]
        p_cmp = jax.nn.softmax(jnp.where(ok, s, NEG_INF), axis=-1) * jnp.any(ok, axis=-1)[:, None].astype(jnp.float32)
        o_cmp = jnp.einsum('bgrqc,bcgd->bqgrd', p_cmp.astype(vc.dtype), vc)
        imp = jnp.einsum('bgrqc,cn->bgqn', p_cmp, overlap)
        blk = jnp.arange(n_sel)[None, :]
        cur = (pos // SEL_BLOCK)[:, None]
        forced = (blk == 0) | ((blk <= cur) & (blk > cur - SEL_LOCAL))
        imp = jnp.where(forced, FORCE_SCORE, jnp.where(blk > cur, -1.0, imp))
        _, idx = lax.top_k(imp, n_topk)
        ks = gather_blocks(kb, idx)
        vs = gather_blocks(vb, idx)
        s = jnp.einsum('bqgrd,bgqkld->bgrqkl', qb, ks).astype(jnp.float32)
        kpos = idx[..., None] * SEL_BLOCK + jnp.arange(SEL_BLOCK)
        rel = pos[None, None, :, None, None] - kpos
        s = s - slopes[None, :, :, None, None, None] * jnp.abs(rel).astype(jnp.float32)[:, :, None]
        s = jnp.where((rel >= 0)[:, :, None], s, NEG_INF)
        p_sel = jax.nn.softmax(s.reshape(bsz, G, R, Q_BLOCK, -1), axis=-1).reshape(s.shape)
        o_sel = jnp.einsum('bgrqkl,bgqkld->bqgrd', p_sel.astype(vs.dtype), vs)
        kwb = lax.dynamic_slice_in_dim(kw, q0, Q_BLOCK + WINDOW, axis=1)
        vwb = lax.dynamic_slice_in_dim(vw, q0, Q_BLOCK + WINDOW, axis=1)
        kwpos = q0 - WINDOW + jnp.arange(Q_BLOCK + WINDOW)
        relw = pos[:, None] - kwpos[None, :]
        okw = (relw >= 0) & (relw < WINDOW) & (kwpos[None, :] >= 0)
        s = jnp.einsum('bqgrd,bkgd->bgrqk', qb, kwb).astype(jnp.float32)
        s = s - slopes[None, :, :, None, None] * jnp.abs(relw).astype(jnp.float32)
        p_win = jax.nn.softmax(jnp.where(okw, s, NEG_INF), axis=-1)
        o_win = jnp.einsum('bgrqk,bkgd->bqgrd', p_win.astype(vwb.dtype), vwb)
        o = gb[..., 0:1] * o_cmp + gb[..., 1:2] * o_sel + gb[..., 2:3] * o_win
        return o.reshape(bsz, Q_BLOCK, NSA_WIDTH)

    out = lax.map(query_block, jnp.arange(seq // Q_BLOCK))
    return out.transpose(1, 0, 2, 3).reshape(bsz, seq, NSA_WIDTH)


def gla_attention(q, k, v, log_a, r, norm_w):
    bsz, seq = q.shape[:2]
    H, C = GLA_HEADS, GLA_CHUNK
    nc = seq // C

    def chunks(t, d):
        return t.astype(jnp.float32).reshape(bsz, nc, C, H, d).transpose(1, 0, 3, 2, 4)

    qc = chunks(q, GLA_DK) * GLA_DK ** -0.5
    kc = chunks(k, GLA_DK)
    vc = chunks(v, GLA_DV)
    ac = chunks(log_a, GLA_DK)
    causal = jnp.tril(jnp.ones((C, C), dtype=bool))[:, :, None]

    def step(state, inp):
        qi, ki, vi, ai = inp
        b = jnp.cumsum(ai, axis=2)
        diff = b[:, :, :, None, :] - b[:, :, None, :, :]
        decay = jnp.exp(jnp.where(causal, diff, -jnp.inf))
        scores = jnp.einsum('bhtd,bhsd,bhtsd->bhts', qi, ki, decay)
        o = scores @ vi + (qi * jnp.exp(b)) @ state
        b_last = b[:, :, -1:, :]
        state = (jnp.exp(b_last[:, :, 0, :, None]) * state +
                 jnp.einsum('bhsd,bhsv->bhdv', ki * jnp.exp(b_last - b), vi))
        return state, o

    s0 = jnp.zeros((bsz, H, GLA_DK, GLA_DV), jnp.float32)
    _, o = lax.scan(step, s0, (qc, kc, vc, ac))
    o = o.transpose(1, 0, 3, 2, 4).reshape(bsz, seq, H, GLA_DV)
    o = o * lax.rsqrt(jnp.mean(jnp.square(o), axis=-1, keepdims=True) + RMS_EPS) * norm_w
    return (o.reshape(bsz, seq, GLA_WIDTH) * jax.nn.silu(r.astype(jnp.float32))).astype(r.dtype)


def moe_ffn(h, w_router, b_router, w_gate_up, b_gate_up, w_down, b_down):
    bsz, seq, d = h.shape
    n_tok = bsz * seq
    n_asg = n_tok * TOP_K
    hf = h.reshape(n_tok, d)
    logits = (hf @ w_router + b_router).astype(jnp.float32)
    top_logits, top_idx = lax.top_k(logits, TOP_K)
    top_w = jax.nn.softmax(top_logits, axis=-1)
    flat_e = top_idx.reshape(n_asg)
    order = jnp.argsort(flat_e)
    sorted_e = flat_e[order]
    counts = jnp.bincount(flat_e, length=N_EXPERTS)
    padded = (counts + MOE_BLOCK - 1) // MOE_BLOCK * MOE_BLOCK
    start = jnp.cumsum(counts) - counts
    ends_p = jnp.cumsum(padded)
    start_p = ends_p - padded
    dest = start_p[sorted_e] + jnp.arange(n_asg, dtype=jnp.int32) - start[sorted_e]
    slot_of = jnp.zeros(n_asg, jnp.int32).at[order].set(dest.astype(jnp.int32))
    n_blocks = -(-n_asg // MOE_BLOCK) + N_EXPERTS
    n_slots = n_blocks * MOE_BLOCK
    slot_token = jnp.zeros(n_slots, jnp.int32).at[slot_of].set(jnp.arange(n_asg, dtype=jnp.int32) // TOP_K)
    slot_w = jnp.zeros(n_slots, jnp.float32).at[slot_of].set(top_w.reshape(n_asg))
    block_expert = jnp.minimum(jnp.searchsorted(ends_p, jnp.arange(n_blocks) * MOE_BLOCK, side='right'),
                               N_EXPERTS - 1)
    xbuf = hf[slot_token].reshape(n_blocks, MOE_BLOCK, d)

    def expert_block(args):
        xb, e = args
        gu = xb @ w_gate_up[e] + b_gate_up[e]
        gate = jnp.minimum(gu[:, :D_FF], SWIGLU_LIMIT)
        up = jnp.clip(gu[:, D_FF:], -SWIGLU_LIMIT, SWIGLU_LIMIT)
        act = (up + 1.0) * gate * jax.nn.sigmoid(SWIGLU_ALPHA * gate)
        return act @ w_down[e] + b_down[e]

    ybuf = lax.map(expert_block, (xbuf, block_expert)).reshape(n_slots, d)
    y = jax.ops.segment_sum(ybuf * slot_w[:, None].astype(ybuf.dtype), slot_token, num_segments=n_tok)
    return y.reshape(bsz, seq, d)


def setup_inputs(seed: int = 0) -> dict:
    key = jax.random.key(seed)
    ks = jax.random.split(key, 27)
    L = DEPTH

    def nrm(k, shape, s):
        return s * jax.random.normal(k, shape, jnp.float32)

    col_scale = jnp.concatenate([jnp.full((w,), DN_BETA if i in VALUE_SEGMENTS else 1.0, jnp.float32)
                                 for i, w in enumerate(PROJ_WIDTHS)])
    return {
        "x": nrm(ks[0], (BATCH, SEQ, D_MODEL), 1.0),
        "c": nrm(ks[1], (BATCH, D_MODEL), 1.0),
        "w_ada": nrm(ks[2], (L, D_MODEL, 6 * D_MODEL), 0.5 * D_MODEL ** -0.5),
        "b_ada": nrm(ks[3], (L, 6 * D_MODEL), 0.02),
        "w_in": nrm(ks[4], (L, D_MODEL, IN_WIDTH), D_MODEL ** -0.5) * col_scale,
        "cmp_pe_k": nrm(ks[5], (L, CMP_BLOCK, HEAD_DIM), 0.02),
        "cmp_w1_k": nrm(ks[6], (L, CMP_BLOCK * HEAD_DIM, CMP_HIDDEN), (CMP_BLOCK * HEAD_DIM) ** -0.5),
        "cmp_b1_k": nrm(ks[7], (L, CMP_HIDDEN), 0.02),
        "cmp_w2_k": nrm(ks[8], (L, CMP_HIDDEN, HEAD_DIM), CMP_HIDDEN ** -0.5),
        "cmp_pe_v": nrm(ks[9], (L, CMP_BLOCK, HEAD_DIM), 0.02),
        "cmp_w1_v": nrm(ks[10], (L, CMP_BLOCK * HEAD_DIM, CMP_HIDDEN), (CMP_BLOCK * HEAD_DIM) ** -0.5),
        "cmp_b1_v": nrm(ks[11], (L, CMP_HIDDEN), 0.02),
        "cmp_w2_v": nrm(ks[12], (L, CMP_HIDDEN, HEAD_DIM), CMP_HIDDEN ** -0.5),
        "gla_w_gate": nrm(ks[13], (L, GLA_GATE_RANK, GLA_HEADS * GLA_DK), GLA_GATE_RANK ** -0.5),
        "gla_b_gate": nrm(ks[14], (L, GLA_HEADS * GLA_DK), 0.1),
        "gla_norm_w": 1.0 + nrm(ks[15], (L, GLA_DV), 0.02),
        "w_out": nrm(ks[16], (L, MIX_WIDTH, D_MODEL), DN_BETA * MIX_WIDTH ** -0.5),
        "ln1_g": 1.0 + nrm(ks[17], (L, D_MODEL), 0.02),
        "ln1_b": nrm(ks[18], (L, D_MODEL), 0.02),
        "w_router": nrm(ks[19], (L, D_MODEL, N_EXPERTS), D_MODEL ** -0.5),
        "b_router": nrm(ks[20], (L, N_EXPERTS), 0.01),
        "w_gate_up": nrm(ks[21], (L, N_EXPERTS, D_MODEL, 2 * D_FF), D_MODEL ** -0.5),
        "b_gate_up": nrm(ks[22], (L, N_EXPERTS, 2 * D_FF), 0.02),
        "w_down": nrm(ks[23], (L, N_EXPERTS, D_FF, D_MODEL), DN_BETA * D_FF ** -0.5),
        "b_down": nrm(ks[24], (L, N_EXPERTS, D_MODEL), 0.02),
        "ln2_g": 1.0 + nrm(ks[25], (L, D_MODEL), 0.02),
        "ln2_b": nrm(ks[26], (L, D_MODEL), 0.02),
    }


def reference(x, c, w_ada, b_ada, w_in, cmp_pe_k, cmp_w1_k, cmp_b1_k, cmp_w2_k,
              cmp_pe_v, cmp_w1_v, cmp_b1_v, cmp_w2_v, gla_w_gate, gla_b_gate, gla_norm_w,
              w_out, ln1_g, ln1_b, w_router, b_router, w_gate_up, b_gate_up, w_down, b_down,
              ln2_g, ln2_b):
    bsz, seq, _ = x.shape
    for l in range(DEPTH):
        mod = jax.nn.silu(c) @ w_ada[l] + b_ada[l]
        sh1, sc1, g1, sh2, sc2, g2 = [m[:, None, :] for m in jnp.split(mod, 6, axis=-1)]
        h = x * (1.0 + sc1) + sh1
        (q_nsa, k_cmp, v_cmp, k_sel, v_sel, k_win, v_win, g_nsa,
         q_gla, k_gla, v_gla, a_gla, r_gla) = split_cols(h @ w_in[l])
        kv_heads = lambda t: t.reshape(bsz, seq, NSA_KV_HEADS, HEAD_DIM)
        y_nsa = nsa_attention(q_nsa.reshape(bsz, seq, NSA_HEADS, HEAD_DIM),
                              kv_heads(k_cmp), kv_heads(v_cmp), kv_heads(k_sel), kv_heads(v_sel),
                              kv_heads(k_win), kv_heads(v_win),
                              jax.nn.sigmoid(g_nsa.reshape(bsz, seq, NSA_HEADS, 3)),
                              cmp_pe_k[l], cmp_w1_k[l], cmp_b1_k[l], cmp_w2_k[l],
                              cmp_pe_v[l], cmp_w1_v[l], cmp_b1_v[l], cmp_w2_v[l])
        log_a = jax.nn.log_sigmoid((a_gla @ gla_w_gate[l] + gla_b_gate[l]).astype(jnp.float32)) / GLA_GATE_TAU
        y_gla = gla_attention(q_gla, k_gla, v_gla, log_a, r_gla, gla_norm_w[l])
        mix = jnp.concatenate([y_nsa, y_gla], axis=-1) @ w_out[l]
        x = layer_norm(DN_ALPHA * x + g1 * mix, ln1_g[l], ln1_b[l])
        h = x * (1.0 + sc2) + sh2
        ffn = moe_ffn(h, w_router[l], b_router[l], w_gate_up[l], b_gate_up[l], w_down[l], b_down[l])
        x = layer_norm(DN_ALPHA * x + g2 * ffn, ln2_g[l], ln2_b[l])
    return x
```

```cpp
#ifndef PROBE_DUP
#define PROBE_DUP -1
#endif
#include <hip/hip_runtime.h>
#include <stdint.h>
#include <stdio.h>

#define LAS __attribute__((address_space(3)))
typedef unsigned short bf16_t;
typedef short bf16x8 __attribute__((ext_vector_type(8)));
typedef short s16x4 __attribute__((ext_vector_type(4)));
typedef float f32x4 __attribute__((ext_vector_type(4)));
typedef float f32x2 __attribute__((ext_vector_type(2)));
typedef float f32x16 __attribute__((ext_vector_type(16)));
typedef unsigned u32x4 __attribute__((ext_vector_type(4)));
typedef unsigned u32x2 __attribute__((ext_vector_type(2)));

constexpr int BATCH = 4, SEQ = 8192, DM = 2048, NTOK = BATCH * SEQ;
constexpr int INW = 5672, INP = 5888;
constexpr int HD = 128, NSA_H = 8, NSA_G = 2, NSA_R = 4;
constexpr int NCMP = 511, NCMPP = 512, CMPH = 256;
constexpr int NSEL = 128, SELK = 16, WIN = 512;
constexpr int GLA_H = 4, GLA_DK = 128, GLA_DV = 256, GLA_C = 64, GLA_NC = SEQ / GLA_C;
constexpr int NEXP = 32, TOPK = 4, DFF = 2048, MOEB = 256;
constexpr int NSLOT_MAX = (NTOK * TOPK / MOEB + NEXP) * MOEB;
constexpr float DN_ALPHA = 1.189207115002721f;
constexpr float LN_EPS = 1e-5f, RMS_EPS = 1e-6f;
#ifndef IN_FP8_MASK
#define IN_FP8_MASK 0x7fffffu
#endif
constexpr unsigned IN_FP8_TILES = IN_FP8_MASK;
constexpr unsigned IN_BF16_TILES = 0x7fffffu & ~IN_FP8_TILES;
constexpr float CSCALE = 4.0f;
constexpr float WSCALE = 64.0f;
constexpr int PC_QN = 0, PC_KC = 1024, PC_VC = 1280, PC_KS = 1536, PC_VS = 1792, PC_KW = 2048, PC_VW = 2304;
constexpr int PC_QG = 2560, PC_KG = 3072, PC_VG = 3584, PC_RG = 4608, PC_GN = 5632, PC_AG = 5656;

constexpr size_t al256(size_t x) { return (x + 255) & ~(size_t)255; }
constexpr size_t WS_CTL = 0;
constexpr size_t CTL_BYTES = 65536;
constexpr size_t CW_BAR = 0;
constexpr size_t CW_CNT = 49152;
constexpr size_t CW_CUR = 49152 + 256;
constexpr size_t CW_Q = 49152 + 1024;
constexpr size_t WS_MOD = WS_CTL + CTL_BYTES;
constexpr size_t WS_CB = WS_MOD + al256((size_t)BATCH * 6 * DM * 4);
constexpr size_t WS_WTIN = WS_CB + 65536;
constexpr size_t WS_WTOUT = WS_WTIN + (size_t)INP * DM * 2;
constexpr size_t WS_W1T = WS_WTOUT + (size_t)DM * DM * 2;
constexpr size_t WS_W2T = WS_W1T + (size_t)2 * CMPH * 4096 * 2;
constexpr size_t WS_WTGU = WS_W2T + (size_t)2 * HD * CMPH * 2;
constexpr size_t WS_WTDN = WS_WTGU + (size_t)NEXP * 4096 * DM * 2;
constexpr size_t WS_H = WS_WTDN + (size_t)NEXP * DM * DFF * 2;
constexpr size_t WS_P = WS_H + (size_t)NTOK * DM * 2;
constexpr size_t WS_HID = WS_P + (size_t)NTOK * INP * 2;
constexpr size_t WS_SLAB = WS_HID + (size_t)2 * 4096 * CMPH * 4;
constexpr size_t WS_KC = WS_SLAB + (size_t)16 * 4096 * CMPH * 4;
constexpr size_t WS_CAT = WS_KC + (size_t)2 * 4096 * HD * 2;
constexpr size_t WS_U1 = WS_CAT + (size_t)NTOK * DM * 2;
constexpr size_t WS_TOPI = WS_U1 + (size_t)NTOK * DM * 4;
constexpr size_t WS_TOPW = WS_TOPI + (size_t)NTOK * 4 * 4;
constexpr size_t WS_SLOT = WS_TOPW + (size_t)NTOK * 4 * 4;
constexpr size_t WS_STOK = WS_SLOT + (size_t)NTOK * 4 * 4;
constexpr size_t WS_XBUF = WS_STOK + al256((size_t)NSLOT_MAX * 4);
constexpr size_t WS_ACT = WS_XBUF + (size_t)NSLOT_MAX * DM * 2;
constexpr size_t WS_SLOC = WS_ACT + (size_t)NSLOT_MAX * DM * 2;
constexpr size_t WS_DEC = WS_SLOC + (size_t)2048 * 128 * 256 * 4;
constexpr size_t WS_STATE = WS_DEC + (size_t)2048 * 128 * 4;
constexpr size_t WS_H8 = WS_STATE + (size_t)2048 * 128 * 256 * 2;
constexpr size_t WS_WTIN8 = WS_H8 + (size_t)NTOK * DM;
constexpr size_t WS_END = WS_WTIN8 + (size_t)INP * DM;

struct Args {
    const float* in[27];
    float* out;
    unsigned char* ws;
    int ph_lo, ph_hi, bar_id, pad0;
};
enum { I_X = 0, I_C, I_WADA, I_BADA, I_WIN, I_PEK, I_W1K, I_B1K, I_W2K, I_PEV, I_W1V, I_B1V, I_W2V, I_GWG, I_GBG, I_GNW, I_WOUT, I_LN1G, I_LN1B,
       I_WR, I_BR, I_WGU, I_BGU, I_WDN, I_BDN, I_LN2G, I_LN2B };

__device__ __forceinline__ int TIDX() { int t_ = threadIdx.x; asm volatile("" : "+v"(t_)); return t_; }
__device__ __forceinline__ bf16_t f2bf(float f) { unsigned u = __float_as_uint(f); u += 0x7FFFu + ((u >> 16) & 1u); return (bf16_t)(u >> 16); }
__device__ __forceinline__ float bf2f(bf16_t h) { return __uint_as_float(((unsigned)h) << 16); }
__device__ __forceinline__ unsigned cvt_pk_bf16(float lo, float hi) { unsigned r; asm volatile("v_cvt_pk_bf16_f32 %0, %1, %2" : "=v"(r) : "v"(lo), "v"(hi)); return r; }
__device__ __forceinline__ unsigned pack_fp8x4(float a, float b, float c, float d) {
    int w = __builtin_amdgcn_cvt_pk_fp8_f32(a, b, 0, false); w = __builtin_amdgcn_cvt_pk_fp8_f32(c, d, w, true); return (unsigned)w; }
__device__ __forceinline__ float wave_sum(float v) {
    v += __int_as_float(__builtin_amdgcn_update_dpp(0, __float_as_int(v), 0xB1, 0xf, 0xf, false));
    v += __int_as_float(__builtin_amdgcn_update_dpp(0, __float_as_int(v), 0x4E, 0xf, 0xf, false));
    v += __int_as_float(__builtin_amdgcn_update_dpp(0, __float_as_int(v), 0x141, 0xf, 0xf, false));
    v += __int_as_float(__builtin_amdgcn_update_dpp(0, __float_as_int(v), 0x128, 0xf, 0xf, false));
    v += __int_as_float(__builtin_amdgcn_ds_swizzle(__float_as_int(v), 0x401F));
    { auto rr = __builtin_amdgcn_permlane32_swap(__float_as_uint(v), __float_as_uint(v), false, false); v = __uint_as_float(rr[0]) + __uint_as_float(rr[1]); }
    return v;
}
__device__ __forceinline__ unsigned wave_or(unsigned v) {
    v |= (unsigned)__builtin_amdgcn_update_dpp(0, (int)v, 0xB1, 0xf, 0xf, false);
    v |= (unsigned)__builtin_amdgcn_update_dpp(0, (int)v, 0x4E, 0xf, 0xf, false);
    v |= (unsigned)__builtin_amdgcn_update_dpp(0, (int)v, 0x141, 0xf, 0xf, false);
    v |= (unsigned)__builtin_amdgcn_update_dpp(0, (int)v, 0x128, 0xf, 0xf, false);
    v |= (unsigned)__builtin_amdgcn_ds_swizzle((int)v, 0x401F);
    { auto rr = __builtin_amdgcn_permlane32_swap(v, v, false, false); v = rr[0] | rr[1]; }
    return v;
}
__device__ __forceinline__ float wave_max(float v) {
#pragma unroll
    for (int o = 32; o >= 1; o >>= 1) v = fmaxf(v, __shfl_xor(v, o));
    return v;
}
__device__ __forceinline__ float sigmoidf_(float x) { return 1.0f / (1.0f + __expf(-x)); }
#define XB_TMO      128
#define XB_XCNT(j)  (256  + 64 * (j))
#define XB_XSUB(j)  (1280 + 64 * (j))
#define XB_XGEN(j)  (2304 + 64 * (j))
#define XB_TOP      3328
#define XB_TOPGEN   3392
#define XCD_BAR_WORDS 3456
#define XB_SPIN_CAP (1u << 18)

__device__ __forceinline__ unsigned xb_ld(unsigned* p)              { return __hip_atomic_load(p, __ATOMIC_RELAXED, __HIP_MEMORY_SCOPE_AGENT); }
__device__ __forceinline__ unsigned xb_add(unsigned* p, unsigned v) { return __hip_atomic_fetch_add(p, v, __ATOMIC_RELAXED, __HIP_MEMORY_SCOPE_AGENT); }
__device__ __forceinline__ unsigned xb_xcc_id() { return (unsigned)__builtin_amdgcn_s_getreg((3 << 11) | 20) & 0xFu; }
#define XB_SPIN(cond, bar) do { unsigned _sp = 0; while (cond) { __builtin_amdgcn_s_sleep(1); \
    if ((++_sp & 255u) == 0u) { if (xb_ld(&(bar)[XB_TMO])) break; if (_sp > XB_SPIN_CAP) { atomicAdd(&(bar)[XB_TMO], 1u); break; } } } } while (0)

struct XcdBarrier {
    unsigned* bar; unsigned x;
    volatile LAS unsigned* st;
};

__device__ __forceinline__ XcdBarrier xcd_barrier_post(unsigned* bar, volatile LAS unsigned* st) {
    XcdBarrier b; b.bar = bar; b.x = xb_xcc_id(); b.st = st;
    if (threadIdx.x == 0) (void)xb_add(&bar[XB_XCNT(b.x)], 1u);
    return b;
}
__device__ __forceinline__ void xcd_barrier_complete(unsigned* bar, unsigned x, unsigned& nloc, unsigned& nx) {
    const unsigned G = gridDim.x * gridDim.y * gridDim.z;
    unsigned sum, cnt, mine, sp = 0u;
    for (;;) {
        sum = 0u; cnt = 0u; mine = 0u;
#pragma unroll
        for (unsigned j = 0; j < 16; ++j) { const unsigned c = xb_ld(&bar[XB_XCNT(j)]); sum += c; cnt += (c > 0u) ? 1u : 0u; mine = (j == x) ? c : mine; }
        if (sum == G) break;
        __builtin_amdgcn_s_sleep(1);
        if ((++sp & 255u) == 0u) { if (xb_ld(&bar[XB_TMO])) break; if (sp > XB_SPIN_CAP) { atomicAdd(&bar[XB_TMO], 1u); break; } }
    }
    nloc = mine > 0u ? mine : 1u; nx = cnt > 0u ? cnt : 1u;
}

__device__ __forceinline__ void xcd_barrier(const XcdBarrier& b) {
    asm volatile("s_waitcnt vmcnt(0)" ::: "memory");
    __syncthreads();
    if (threadIdx.x == 0) {
        unsigned* bar = b.bar;
        __builtin_amdgcn_s_waitcnt(0);
        unsigned nloc = b.st[0], nx = b.st[1];
        if (nloc == 0u) { xcd_barrier_complete(bar, b.x, nloc, nx); b.st[0] = nloc; b.st[1] = nx; }
        const unsigned old = xb_add(&bar[XB_XSUB(b.x)], 1u);
        const unsigned gen = old / nloc;
        if (old + 1u == (gen + 1u) * nloc) {
            __builtin_amdgcn_fence(__ATOMIC_RELEASE, "agent");
            asm volatile("s_waitcnt vmcnt(0)" ::: "memory");
            const unsigned og = xb_add(&bar[XB_TOP], 1u);
            const unsigned tg = og / nx;
            if (og + 1u == (tg + 1u) * nx) xb_add(&bar[XB_TOPGEN], 1u);
            else XB_SPIN(xb_ld(&bar[XB_TOPGEN]) == tg, bar);
            __builtin_amdgcn_fence(__ATOMIC_ACQUIRE, "agent");
            xb_add(&bar[XB_XGEN(b.x)], 1u);
            asm volatile("s_waitcnt vmcnt(0)" ::: "memory");
        } else {
            XB_SPIN(xb_ld(&bar[XB_XGEN(b.x)]) == gen, bar);
            __builtin_amdgcn_fence(__ATOMIC_ACQUIRE, "agent");
            asm volatile("s_waitcnt vmcnt(0)" ::: "memory");
        }
    }
    __syncthreads();
}
namespace pg8 {
typedef int i32x4 __attribute__((ext_vector_type(4)));
typedef int i32x8 __attribute__((ext_vector_type(8)));
constexpr int BM = 256, BK = 64, HALF = 128, HTB = HALF * BK * 2, STAGE_BYTES = 8 * HTB, NXCD = 8, WGM = 8;
__host__ __device__ __forceinline__ int lds_byte(int r, int c) { const int st = (r >> 4) * 2 + (c >> 5), rr = r & 15, cc = c & 31, ob = rr * 64 + cc * 2; return st * 1024 + (ob ^ (((ob >> 9) & 1) << 5)); }
__host__ __device__ __forceinline__ void stage_rc(int b, int& R, int& C) { const int st = b / 1024, sb = b % 1024, swz = sb ^ (((sb >> 9) & 1) << 5); R = (st >> 1) * 16 + swz / 64; C = (st & 1) * 32 + (swz % 64) / 2; }
__host__ __device__ __forceinline__ int perm32(int rho) { const int n = rho >> 4, i = rho & 15; return 8 * (i >> 2) + 4 * n + (i & 3); }

struct Unit { int pm, pn, e, li; size_t aoff, boff; };
struct AMapPlain { static constexpr bool GATHER = false; size_t ldab;
    __device__ __forceinline__ unsigned voff(int R, int C) const { return (unsigned)(R * ldab + C * 2); }
    __device__ __forceinline__ size_t hstep() const { return (size_t)HALF * ldab; }
    __device__ __forceinline__ size_t kS0() const { return 128; }
    __device__ __forceinline__ size_t kS1() const { return 256; } };
struct AMapGather { static constexpr bool GATHER = true; size_t ldab; const LAS unsigned short* tok;
    __device__ __forceinline__ unsigned voff(int R, int C) const { return (unsigned)(C * 2); }
    __device__ __forceinline__ size_t hstep() const { return 0; }
    __device__ __forceinline__ size_t kS0() const { return 128; }
    __device__ __forceinline__ size_t kS1() const { return 256; }
    __device__ __forceinline__ unsigned row_off(int li, int r) const { return (unsigned)tok[li * 256 + r] * (unsigned)ldab; } };
struct Gemm { const void* A; const void* Bt; int nt; size_t ldbb; };

struct StaticOrder {
    int nM, nN, nwg, G, c; unsigned mask;
    __device__ void init(int M, int N, int G_, int c_, unsigned mask_ = 0u) { nM = M / BM; nN = mask_ ? __builtin_popcount(mask_) : N / BM; nwg = nM * nN; G = G_; c = c_; mask = mask_; }
    __device__ bool next(int i, Unit& u) const {
        const long L = (long)i * G + c; if (L >= nwg) return false;
        int wgid = (int)L; { const int q = nwg / NXCD, r = nwg % NXCD, xcd = wgid % NXCD, off = wgid / NXCD; wgid = (xcd < r ? xcd * (q + 1) : r * (q + 1) + (xcd - r) * q) + off; }
        const int nig = WGM * nN, gid = wgid / nig, fm = gid * WGM, gsz = (nM - fm) < WGM ? (nM - fm) : WGM;
        u.pm = fm + ((wgid % nig) % gsz); u.pn = (wgid % nig) / gsz; u.e = 0; u.li = i;
        if (mask) { unsigned m = mask; for (int k = 0; k < u.pn; ++k) m &= m - 1; u.pn = __builtin_ctz(m); } u.aoff = 0; u.boff = 0; return true;
    }
};
struct MoeOrder {
    const LAS int* tile_e; int ntile, nN, G, c; size_t strideE;
    __device__ bool map(int i, int& pm, int& pn) const {
        if (G == 256) { const int PX = nN >> 2, x = c & 7, j = c >> 3; pm = (i * (8 / PX) + x / PX) * 8 + (j & 7); pn = (x % PX) * 4 + (j >> 3); return pm < ntile; }
        const long L = (long)i * G + c; pm = (int)(L / nN); pn = (int)(L % nN); return L < (long)ntile * nN;
    }
    __device__ bool next(int i, Unit& u) const {
        int pm, pn; if (!map(i, pm, pn)) return false;
        u.pm = pm; u.pn = pn; u.e = tile_e[pm]; u.li = i; u.aoff = 0; u.boff = (size_t)u.e * strideE; return true;
    }
};

struct MoeChunkOrder {
    const LAS int* tile_e; int base, cnt, nN; size_t strideE;
    __device__ bool next(int i, Unit& u) const {
        if (i >= cnt) return false; const int L = base + i;
        u.pm = L / nN; u.pn = L % nN; u.e = tile_e[u.pm]; u.li = i; u.aoff = 0; u.boff = (size_t)u.e * strideE; return true;
    }
};
struct MoeXcdOrder {
    const LAS int* tile_e; int base, cnt, x; size_t strideE;
    __device__ bool next(int i, Unit& u) const {
        if (i >= cnt) return false; const int L = base + i;
        u.pm = L >> 1; u.pn = 2 * x + (L & 1); u.e = tile_e[u.pm]; u.li = i; u.aoff = 0; u.boff = (size_t)u.e * strideE; return true;
    }
};
struct CmpOrder { int G, c;
    __device__ bool next(int i, Unit& u) const {
        const int L = i * G + c; if (L >= 256) return false;
        const int kv = L >> 7, ks = L & 7; u.pm = (L >> 3) & 15; u.pn = 0; u.e = kv * 8 + ks; u.li = i;
        u.aoff = ((size_t)kv * 256 + (size_t)ks * 4 * INP) * 2; u.boff = ((size_t)kv * CMPH * 4096 + (size_t)ks * 512) * 2; return true; } };
struct AMapCmp { static constexpr bool GATHER = false;
    __device__ __forceinline__ unsigned voff(int R, int C) const { return (unsigned)((R >> 1) * 16 * INP + (R & 1) * 128 + PC_KC + C) * 2u; }
    __device__ __forceinline__ size_t hstep() const { return (size_t)64 * 16 * INP * 2; }
    __device__ __forceinline__ size_t kS0() const { return 128; }
    __device__ __forceinline__ size_t kS1() const { return (size_t)INP * 2; } };
#define PG8_ASM_LOAD16(dst, ptr) asm volatile("global_load_dwordx4 %0, %1, off" : "=v"(dst) : "v"(ptr))
struct EpiBf16Plain {
    static constexpr bool PERM = true;
    bf16_t* O; int ldc; const float* bias; int bias_ld; float scale;
    __device__ __forceinline__ void pre(f32x4 (&pv)[4], const Unit& u, int wc, int fq) const {
        const int col0 = u.pn * BM + wc * 32 + 8 * fq;
#pragma unroll
        for (int q = 0; q < 4; ++q) { if (bias) PG8_ASM_LOAD16(pv[q], bias + (size_t)u.e * bias_ld + col0 + (q >> 1) * HALF + 4 * (q & 1)); else pv[q] = (f32x4){0.f, 0.f, 0.f, 0.f}; }
    }
    __device__ __forceinline__ void operator()(const f32x4 (&acc)[2][2][4][2], const Unit& u, int wr, int wc, int fr, int fq, const f32x4 (&pv)[4]) const {
        const int row0 = u.pm * BM + wr * 64 + fr, col0 = u.pn * BM + wc * 32 + 8 * fq;
        f32x4 bv[2][2];
#pragma unroll
        for (int bj = 0; bj < 2; ++bj)
#pragma unroll
            for (int n = 0; n < 2; ++n) bv[bj][n] = pv[bj * 2 + n];
#pragma unroll
        for (int ai = 0; ai < 2; ++ai)
#pragma unroll
            for (int m = 0; m < 4; ++m) { bf16_t* rowp = O + (size_t)(row0 + ai * HALF + m * 16) * ldc + col0;
#pragma unroll
                for (int bj = 0; bj < 2; ++bj) { const f32x4 v0 = acc[ai][bj][m][0] * scale + bv[bj][0], v1 = acc[ai][bj][m][1] * scale + bv[bj][1];
                    u32x4 w; w.x = cvt_pk_bf16(v0[0], v0[1]); w.y = cvt_pk_bf16(v0[2], v0[3]); w.z = cvt_pk_bf16(v1[0], v1[1]); w.w = cvt_pk_bf16(v1[2], v1[3]);
                    *(u32x4*)(rowp + bj * HALF) = w; } }
    }
};
struct EpiF32Plain {
    static constexpr bool PERM = false;
    float* C0; int ldc; size_t estride;
    __device__ __forceinline__ void pre(f32x4 (&pv)[4], const Unit&, int, int) const { pv[0] = pv[1] = pv[2] = pv[3] = (f32x4){0.f, 0.f, 0.f, 0.f}; }
    __device__ __forceinline__ void operator()(const f32x4 (&acc)[2][2][4][2], const Unit& u, int wr, int wc, int fr, int fq, const f32x4 (&)[4]) const {
        float* C = C0 + (size_t)u.e * estride;
        const int row0 = u.pm * BM + wr * 64 + fr, col0 = u.pn * BM + wc * 32 + 4 * fq;
#pragma unroll
        for (int ai = 0; ai < 2; ++ai)
#pragma unroll
            for (int m = 0; m < 4; ++m) { float* rowp = C + (size_t)(row0 + ai * HALF + m * 16) * ldc + col0;
#pragma unroll
                for (int bj = 0; bj < 2; ++bj)
#pragma unroll
                    for (int n = 0; n < 2; ++n) *(f32x4*)(rowp + bj * HALF + n * 16) = acc[ai][bj][m][n]; }
    }
};
struct EpiResid {
    static constexpr bool PERM = false;
    float* C; const float* X; const float* gate  ; float scale;
    __device__ __forceinline__ void pre(f32x4 (&pv)[4], const Unit&, int, int) const { pv[0] = pv[1] = pv[2] = pv[3] = (f32x4){0.f, 0.f, 0.f, 0.f}; }
    __device__ __forceinline__ void operator()(const f32x4 (&acc)[2][2][4][2], const Unit& u, int wr, int wc, int fr, int fq, const f32x4 (&)[4]) const {
        const int row0 = u.pm * BM + wr * 64 + fr, col0 = u.pn * BM + wc * 32 + 4 * fq;
        const int b = (u.pm * BM) / SEQ;
        f32x4 gv[2][2];
#pragma unroll
        for (int bj = 0; bj < 2; ++bj)
#pragma unroll
            for (int n = 0; n < 2; ++n) gv[bj][n] = *(const f32x4*)(gate + (size_t)b * 6 * DM + col0 + bj * HALF + n * 16) * scale;
        f32x4 xv[2][4];
#define PG8_XLOAD(G_, BUF) do { const size_t ro_ = (size_t)(row0 + ((G_) >> 2) * HALF + ((G_) & 3) * 16) * DM + col0; _Pragma("unroll") for (int q_ = 0; q_ < 4; ++q_) xv[BUF][q_] = *(const f32x4*)(X + ro_ + (q_ >> 1) * HALF + (q_ & 1) * 16); } while (0)
        PG8_XLOAD(0, 0);
#pragma unroll
        for (int gi = 0; gi < 8; ++gi) { const int ai = gi >> 2, m = gi & 3; const size_t ro = (size_t)(row0 + ai * HALF + m * 16) * DM + col0;
            if (gi + 1 < 8) PG8_XLOAD(gi + 1, (gi + 1) & 1);
#pragma unroll
            for (int q = 0; q < 4; ++q) { const int bj = q >> 1, n = q & 1;
                *(f32x4*)(C + ro + bj * HALF + n * 16) = xv[gi & 1][q] * DN_ALPHA + gv[bj][n] * acc[ai][bj][m][n]; } }
#undef PG8_XLOAD
    }
};
struct EpiGate {
    static constexpr bool PERM = true;
    bf16_t* O; int ldc; const float* gate  ;
    __device__ __forceinline__ void pre(f32x4 (&pv)[4], const Unit& u, int wc, int fq) const {
        const int col0 = u.pn * BM + wc * 32 + 8 * fq, b = (u.pm * BM) / SEQ;
#pragma unroll
        for (int q = 0; q < 4; ++q) PG8_ASM_LOAD16(pv[q], gate + (size_t)b * 6 * DM + col0 + (q >> 1) * HALF + 4 * (q & 1));
    }
    __device__ __forceinline__ void operator()(const f32x4 (&acc)[2][2][4][2], const Unit& u, int wr, int wc, int fr, int fq, const f32x4 (&pv)[4]) const {
        const int row0 = u.pm * BM + wr * 64 + fr, col0 = u.pn * BM + wc * 32 + 8 * fq;
#pragma unroll
        for (int ai = 0; ai < 2; ++ai)
#pragma unroll
            for (int m = 0; m < 4; ++m) { bf16_t* rowp = O + (size_t)(row0 + ai * HALF + m * 16) * ldc + col0;
#pragma unroll
                for (int bj = 0; bj < 2; ++bj) { const f32x4 v0 = acc[ai][bj][m][0] * pv[bj * 2], v1 = acc[ai][bj][m][1] * pv[bj * 2 + 1];
                    u32x4 w; w.x = cvt_pk_bf16(v0[0], v0[1]); w.y = cvt_pk_bf16(v0[2], v0[3]); w.z = cvt_pk_bf16(v1[0], v1[1]); w.w = cvt_pk_bf16(v1[2], v1[3]);
                    *(u32x4*)(rowp + bj * HALF) = w; } }
    }
};
struct EpiSwiglu {
    static constexpr bool PERM = true;
    unsigned char* O; const float* bias; float scale;
    __device__ __forceinline__ void pre(f32x4 (&pv)[4], const Unit& u, int wc, int fq) const {
        const float* bg = bias + (size_t)u.e * 4096 + u.pn * HALF + wc * 32 + 8 * fq;
        PG8_ASM_LOAD16(pv[0], bg); PG8_ASM_LOAD16(pv[1], bg + 4); PG8_ASM_LOAD16(pv[2], bg + DFF); PG8_ASM_LOAD16(pv[3], bg + DFF + 4);
    }
    __device__ __forceinline__ void operator()(const f32x4 (&acc)[2][2][4][2], const Unit& u, int wr, int wc, int fr, int fq, const f32x4 (&pv)[4]) const {
        const int row0 = u.pm * BM + wr * 64 + fr, j0 = u.pn * HALF + wc * 32 + 8 * fq;
        f32x4 bgv[2], buv[2];
        bgv[0] = pv[0]; bgv[1] = pv[1]; buv[0] = pv[2]; buv[1] = pv[3];
#pragma unroll
        for (int ai = 0; ai < 2; ++ai)
#pragma unroll
            for (int m = 0; m < 4; ++m) { unsigned char* rowp = O + (size_t)(row0 + ai * HALF + m * 16) * DFF + j0;
                float r[8];
#pragma unroll
                for (int n = 0; n < 2; ++n) { const f32x4 g = acc[ai][0][m][n] * scale + bgv[n], up = acc[ai][1][m][n] * scale + buv[n];
#pragma unroll
                    for (int j = 0; j < 4; ++j) { const float gg = fminf(g[j], 7.0f), uu = fminf(fmaxf(up[j], -7.0f), 7.0f);
                        r[4 * n + j] = (uu + 1.0f) * gg * __builtin_amdgcn_rcpf(1.0f + __expf(-1.702f * gg)); } }
                u32x2 w; w.x = pack_fp8x4(r[0], r[1], r[2], r[3]); w.y = pack_fp8x4(r[4], r[5], r[6], r[7]);
                *(u32x2*)rowp = w; }
    }
};

template <int OPK  , class Epi, class Sched, class AMap>
__device__ __forceinline__ void gemm_phase(LAS unsigned char* lds, const Gemm g, const Sched& S, const Epi& E, const AMap& AM) {
    const int tid = TIDX(), wid = __builtin_amdgcn_readfirstlane(tid >> 6), lane = tid & 63, wr = wid >> 2, wc = wid & 3, fr = lane & 15, fq = lane >> 4;
    const int nt = g.nt;
    unsigned voffA[2], voffB[2];
#pragma unroll
    for (int i = 0; i < 2; ++i) { int R, C; stage_rc(tid * 16 + i * 8192, R, C); const int Rb = Epi::PERM ? ((R & ~31) + perm32(R & 31)) : R;
        voffA[i] = AM.voff(R, C); voffB[i] = (unsigned)(Rb * g.ldbb + C * 2); }
    unsigned vA0[2], vA1[2], nA0[2], nA1[2];
#define PG8_UNIT_OFFS(U, D0, D1) do { _Pragma("unroll") for (int _i = 0; _i < 2; ++_i) { if constexpr (AMap::GATHER) { int R_, C_; stage_rc(TIDX() * 16 + _i * 8192, R_, C_); \
            D0[_i] = AM.row_off((U).li, R_) + (unsigned)(C_ * 2); D1[_i] = AM.row_off((U).li, HALF + R_) + (unsigned)(C_ * 2); } else { D0[_i] = voffA[_i]; D1[_i] = voffA[_i]; } } } while (0)
    const size_t kstepB = (size_t)(BK * 2);
    const size_t hstepB = (size_t)HALF * g.ldbb, tstepB = 2 * hstepB;
    const size_t hstepA = AM.hstep(), tstepA = 2 * hstepA, kS0 = AM.kS0(), kS1 = AM.kS1();
    const unsigned ldsw = (unsigned)wid * 1024u;
    const int aoff = lds_byte(wr * 64 + fr, fq * 8), boff = lds_byte(wc * 32 + fr, fq * 8);
#define PG8_SA(b, h) (((b) * 2 + (h)) * HTB)
#define PG8_SB(b, h) ((4 + (b) * 2 + (h)) * HTB)
#define PG8_STAGE(bufoff, gbase, voff) do { _Pragma("unroll") for (int _i = 0; _i < 2; ++_i) \
        __builtin_amdgcn_global_load_lds((const unsigned*)((const char*)(gbase) + (voff)[_i]), (LAS unsigned*)(lds + (bufoff) + ldsw + _i * 8192), 16, 0, 0); } while (0)
#define PG8_LDA(dst, b, h) do { _Pragma("unroll") for (int m = 0; m < 4; ++m) { const i32x4 lo_ = *(const LAS i32x4*)(lds + PG8_SA(b, h) + aoff + m * 2048), hi_ = *(const LAS i32x4*)(lds + PG8_SA(b, h) + aoff + m * 2048 + 1024); \
        dst[m] = __builtin_shufflevector(lo_, hi_, 0, 1, 2, 3, 4, 5, 6, 7); } } while (0)
#define PG8_LDB(dst, b, h) do { _Pragma("unroll") for (int n = 0; n < 2; ++n) { const i32x4 lo_ = *(const LAS i32x4*)(lds + PG8_SB(b, h) + boff + n * 2048), hi_ = *(const LAS i32x4*)(lds + PG8_SB(b, h) + boff + n * 2048 + 1024); \
        dst[n] = __builtin_shufflevector(lo_, hi_, 0, 1, 2, 3, 4, 5, 6, 7); } } while (0)
#define PG8_MMA(ai, bj, At, Bt) do { __builtin_amdgcn_s_setprio(1); _Pragma("unroll") for (int m = 0; m < 4; ++m) _Pragma("unroll") for (int n = 0; n < 2; ++n) { \
        if (OPK == 0) { \
            acc[ai][bj][m][n] = __builtin_amdgcn_mfma_f32_16x16x32_bf16(__builtin_bit_cast(bf16x8, __builtin_shufflevector(Bt[n], Bt[n], 0, 1, 2, 3)), __builtin_bit_cast(bf16x8, __builtin_shufflevector(At[m], At[m], 0, 1, 2, 3)), acc[ai][bj][m][n], 0, 0, 0); \
            acc[ai][bj][m][n] = __builtin_amdgcn_mfma_f32_16x16x32_bf16(__builtin_bit_cast(bf16x8, __builtin_shufflevector(Bt[n], Bt[n], 4, 5, 6, 7)), __builtin_bit_cast(bf16x8, __builtin_shufflevector(At[m], At[m], 4, 5, 6, 7)), acc[ai][bj][m][n], 0, 0, 0); } \
        else asm volatile("v_mfma_scale_f32_16x16x128_f8f6f4 %0, %1, %2, %0, %3, %3 op_sel_hi:[0,0,0]" : "+v"(acc[ai][bj][m][n]) : "v"(Bt[n]), "v"(At[m]), "v"(scl1)); } \
        __builtin_amdgcn_s_setprio(0); } while (0)
#define PG8_WAIT_V(n) asm volatile("s_waitcnt vmcnt(" #n ")" ::: "memory")
#define PG8_WAIT_L(n) asm volatile("s_waitcnt lgkmcnt(" #n ")" ::: "memory")
#define PG8_BAR __builtin_amdgcn_s_barrier()
#define PG8_SCHED __builtin_amdgcn_sched_barrier(0)
    Unit cur, nxt; int ui = 0;
    if (!S.next(0, cur)) return;
    int scl1 = 0x7f7f7f7f; asm volatile("" : "+v"(scl1));
    f32x4 acc[2][2][4][2];
#pragma unroll
    for (int a = 0; a < 2; ++a)
#pragma unroll
        for (int b = 0; b < 2; ++b)
#pragma unroll
            for (int m = 0; m < 4; ++m)
#pragma unroll
                for (int n = 0; n < 2; ++n) acc[a][b][m][n] = (f32x4){0.f, 0.f, 0.f, 0.f};
    i32x8 At[4], B0[2], B1[2];
    const char* cA = (const char*)g.A + cur.aoff + (size_t)cur.pm * tstepA; const char* cB = (const char*)g.Bt + cur.boff + (size_t)cur.pn * tstepB;
    PG8_UNIT_OFFS(cur, vA0, vA1);
    f32x4 epv[4]; E.pre(epv, cur, wc, fq);
    PG8_STAGE(PG8_SB(0, 0), cB, voffB); PG8_STAGE(PG8_SA(0, 0), cA, vA0); PG8_STAGE(PG8_SB(0, 1), cB + hstepB, voffB); PG8_STAGE(PG8_SA(0, 1), cA + hstepA, vA1);
    if (wr == 1) PG8_BAR;
    PG8_WAIT_V(4); PG8_BAR;
    PG8_STAGE(PG8_SB(1, 0), cB + kstepB, voffB); PG8_STAGE(PG8_SA(1, 0), cA + kS0, vA0); PG8_STAGE(PG8_SB(1, 1), cB + hstepB + kstepB, voffB);
    PG8_WAIT_V(6); PG8_BAR;
    for (;;) {
        const bool has_next = S.next(ui + 1, nxt);
        const char* nA = has_next ? (const char*)g.A + nxt.aoff + (size_t)nxt.pm * tstepA : cA; const char* nB = has_next ? (const char*)g.Bt + nxt.boff + (size_t)nxt.pn * tstepB : cB;
        if (has_next) PG8_UNIT_OFFS(nxt, nA0, nA1); else { nA0[0] = vA0[0]; nA0[1] = vA0[1]; nA1[0] = vA1[0]; nA1[1] = vA1[1]; }
        for (int t = 0; t < nt; t += 2) {
            const bool last = (t == nt - 2);
            const char* a1 = cA + (size_t)(t >> 1) * kS1 + kS0;
            const char* a2 = last ? nA : cA + (size_t)((t >> 1) + 1) * kS1; const char* b2 = last ? nB : cB + (size_t)(t + 2) * kstepB;
            const char* a3 = a2 + kS0; const char* b3 = b2 + kstepB;
            unsigned s0[2], s1[2];
            s0[0] = last ? nA0[0] : vA0[0]; s0[1] = last ? nA0[1] : vA0[1]; s1[0] = last ? nA1[0] : vA1[0]; s1[1] = last ? nA1[1] : vA1[1];
            PG8_LDB(B0, 0, 0); PG8_SCHED; PG8_LDA(At, 0, 0); PG8_STAGE(PG8_SA(1, 1), a1 + hstepA, vA1);
            PG8_WAIT_L(8); PG8_BAR; PG8_WAIT_L(0); PG8_MMA(0, 0, At, B0); PG8_BAR; PG8_SCHED;
            PG8_LDB(B1, 0, 1); PG8_STAGE(PG8_SB(0, 0), b2, voffB);
            PG8_BAR; PG8_WAIT_L(0); PG8_MMA(0, 1, At, B1); PG8_BAR;
            PG8_LDA(At, 0, 1); PG8_STAGE(PG8_SA(0, 0), a2, s0);
            PG8_BAR; PG8_WAIT_L(0); PG8_MMA(1, 0, At, B0); PG8_BAR; PG8_SCHED;
            PG8_STAGE(PG8_SB(0, 1), b2 + hstepB, voffB);
            PG8_WAIT_V(6); PG8_BAR; PG8_MMA(1, 1, At, B1); PG8_BAR;
            PG8_LDB(B0, 1, 0); PG8_SCHED; PG8_LDA(At, 1, 0); PG8_STAGE(PG8_SA(0, 1), a2 + hstepA, s1);
            PG8_WAIT_L(8); PG8_BAR; PG8_WAIT_L(0); PG8_MMA(0, 0, At, B0); PG8_BAR; PG8_SCHED;
            PG8_LDB(B1, 1, 1); PG8_STAGE(PG8_SB(1, 0), b3, voffB);
            PG8_BAR; PG8_WAIT_L(0); PG8_MMA(0, 1, At, B1); PG8_BAR;
            PG8_LDA(At, 1, 1); PG8_STAGE(PG8_SA(1, 0), a3, s0);
            PG8_BAR; PG8_WAIT_L(0); PG8_MMA(1, 0, At, B0); PG8_BAR; PG8_SCHED;
            PG8_STAGE(PG8_SB(1, 1), b3 + hstepB, voffB);
            PG8_WAIT_V(6); PG8_BAR; PG8_MMA(1, 1, At, B1); PG8_BAR;
        }
        if (OPK == 1) asm volatile("s_nop 15\n\ts_nop 15" ::: "memory");
        { int tz = TIDX();
          const int wid2 = __builtin_amdgcn_readfirstlane(tz >> 6), lane2 = tz & 63;
          asm volatile("s_waitcnt vmcnt(6)" : "+v"(epv[0]), "+v"(epv[1]), "+v"(epv[2]), "+v"(epv[3]) :: "memory");
          E(acc, cur, wid2 >> 2, wid2 & 3, lane2 & 15, lane2 >> 4, epv);
          if (has_next) E.pre(epv, nxt, wid2 & 3, lane2 >> 4); }
        if (!has_next) break;
#pragma unroll
        for (int a = 0; a < 2; ++a)
#pragma unroll
            for (int b = 0; b < 2; ++b)
#pragma unroll
                for (int m = 0; m < 4; ++m)
#pragma unroll
                    for (int n = 0; n < 2; ++n) acc[a][b][m][n] = (f32x4){0.f, 0.f, 0.f, 0.f};
        cur = nxt; cA = nA; cB = nB; ++ui; vA0[0] = nA0[0]; vA0[1] = nA0[1]; vA1[0] = nA1[0]; vA1[1] = nA1[1];
    }
    PG8_WAIT_V(0);
    if (wr == 0) PG8_BAR;
    PG8_BAR;
#undef PG8_UNIT_OFFS
#undef PG8_SA
#undef PG8_SB
#undef PG8_STAGE
#undef PG8_LDA
#undef PG8_LDB
#undef PG8_MMA
#undef PG8_WAIT_V
#undef PG8_WAIT_L
#undef PG8_BAR
#undef PG8_SCHED
}
}
constexpr int NT = 512;
constexpr unsigned IN_FP8_TILES_DECL = 0u;
constexpr int LDS_STAGE = 131072;
constexpr int LDS_MISC = 131072;
constexpr int LDS_BYTES = 163840;

__device__ __forceinline__ void phase_mod(const Args& a, LAS unsigned char* lds) {
    const int tid = TIDX();
    LAS float* sc = (LAS float*)lds;
    LAS float* red = (LAS float*)(lds + 32768);
    const float* c = a.in[I_C]; const float* w = a.in[I_WADA]; const float* bb = a.in[I_BADA];
    float* mod = (float*)(a.ws + WS_MOD);
    bool staged = false;
    for (int u = blockIdx.x; u < 192; u += gridDim.x) {
        if (!staged) { for (int i = tid; i < BATCH * DM; i += NT) { const float v = c[i]; sc[i] = v / (1.0f + __expf(-v)); } staged = true; }
        __syncthreads();
        const int c4 = (tid & 15) * 4, ks = tid >> 4;
        const int col = u * 64 + c4;
        f32x4 acc[4];
#pragma unroll
        for (int b = 0; b < 4; ++b) acc[b] = (f32x4){0.f, 0.f, 0.f, 0.f};
#pragma unroll 8
        for (int i = 0; i < 64; ++i) { const int k = ks * 64 + i; const f32x4 wv = *(const f32x4*)(w + (size_t)k * (6 * DM) + col);
#pragma unroll
            for (int b = 0; b < 4; ++b) acc[b] += wv * sc[b * DM + k]; }
#pragma unroll
        for (int b = 0; b < 4; ++b)
#pragma unroll
            for (int j = 0; j < 4; ++j) red[(ks * 4 + b) * 64 + c4 + j] = acc[b][j];
        __syncthreads();
        if (tid < 256) { const int b = tid >> 6, cc = tid & 63; float s = bb[u * 64 + cc];
            for (int k2 = 0; k2 < 32; ++k2) s += red[(k2 * 4 + b) * 64 + cc];
            mod[(size_t)b * (6 * DM) + u * 64 + cc] = s; }
        __syncthreads();
    }
}

__device__ __forceinline__ int map_col4(int mode, int n) {
    if (mode == 0) return n;
    if (mode == 2) { const int t256 = n >> 8, within = n & 255, half = within >> 7; return half * DFF + t256 * 128 + (within & 127); }
    if (n < 2560) return n;
    if (n < 4608) return n + 24;
    if (n < 5632) return n + 40;
    if (n < 5656) return 2560 + (n - 5632);
    if (n < 5672) return 4632 + (n - 5656);
    return -1;
}
__device__ __forceinline__ void convT_unit(const float* src, int ld, bf16_t* dst, int K, int k0, int n0, int mode, LAS unsigned char* lds) {
    const int tid = TIDX(), l = tid & 63, r = tid >> 6;
    const int sc = map_col4(mode, n0 + 4 * l);
    f32x4 v[8];
    const int scl = sc >= 0 ? sc : 0; const float keep = sc >= 0 ? 1.0f : 0.0f;
#pragma unroll
    for (int i = 0; i < 8; ++i) v[i] = *(const f32x4*)(src + (size_t)(k0 + 8 * r + i) * ld + scl) * keep;
#pragma unroll
    for (int j = 0; j < 4; ++j) { const int n = 4 * l + j;
        u32x4 w; w.x = cvt_pk_bf16(v[0][j], v[1][j]); w.y = cvt_pk_bf16(v[2][j], v[3][j]); w.z = cvt_pk_bf16(v[4][j], v[5][j]); w.w = cvt_pk_bf16(v[6][j], v[7][j]);
        *(LAS u32x4*)(lds + n * 128 + ((r ^ ((n >> 2) & 7)) << 4)) = w; }
    __syncthreads();
#pragma unroll
    for (int j = 0; j < 4; ++j) { const int n = (tid >> 3) + 64 * j, kc = tid & 7;
        const u32x4 w = *(const LAS u32x4*)(lds + n * 128 + ((kc ^ ((n >> 2) & 7)) << 4));
        *(u32x4*)(dst + (size_t)(n0 + n) * K + k0 + 8 * kc) = w; }
    __syncthreads();
}
__device__ __forceinline__ void convT_unit_fp8(const float* src, int ld, unsigned char* dst, int K, int k0, int n0, int mode, LAS unsigned char* lds) {
    const int tid = TIDX(), l = tid & 63, r = tid >> 6;
    const int sc = map_col4(mode, n0 + 4 * l);
    f32x4 v[16];
    const int scl = sc >= 0 ? sc : 0; const float keep = sc >= 0 ? WSCALE : 0.0f;
#pragma unroll
    for (int i = 0; i < 16; ++i) v[i] = *(const f32x4*)(src + (size_t)(k0 + 16 * r + i) * ld + scl) * keep;
#pragma unroll
    for (int j = 0; j < 4; ++j) { const int n = 4 * l + j;
        u32x4 w; w.x = pack_fp8x4(v[0][j], v[1][j], v[2][j], v[3][j]); w.y = pack_fp8x4(v[4][j], v[5][j], v[6][j], v[7][j]);
        w.z = pack_fp8x4(v[8][j], v[9][j], v[10][j], v[11][j]); w.w = pack_fp8x4(v[12][j], v[13][j], v[14][j], v[15][j]);
        *(LAS u32x4*)(lds + n * 128 + ((r ^ ((n >> 2) & 7)) << 4)) = w; }
    __syncthreads();
#pragma unroll
    for (int j = 0; j < 4; ++j) { const int n = (tid >> 3) + 64 * j, kc = tid & 7;
        const u32x4 w = *(const LAS u32x4*)(lds + n * 128 + ((kc ^ ((n >> 2) & 7)) << 4));
        *(u32x4*)(dst + (size_t)(n0 + n) * K + k0 + 16 * kc) = w; }
    __syncthreads();
}
struct ConvJob { const float* src; int ld; bf16_t* dst; int K, Np, mode; };
__device__ __forceinline__ void run_conv_job(const ConvJob& j, int u0, int ustride, LAS unsigned char* lds) {
    const int nkt = j.K / 64, nnt = j.Np / 256, total = nkt * nnt;
    for (int u = u0; u < total; u += ustride) { const int kt = u % nkt, ntl = u / nkt; convT_unit(j.src, j.ld, j.dst, j.K, kt * 64, ntl * 256, j.mode, lds); }
}
__device__ __forceinline__ void phase_conv_small(const Args& a, LAS unsigned char* lds) {
    ConvJob j; if (IN_BF16_TILES) { j = ConvJob{a.in[I_WIN], INW, (bf16_t*)(a.ws + WS_WTIN), DM, INP, 1}; run_conv_job(j, blockIdx.x, gridDim.x, lds); }
    if (IN_FP8_TILES) for (int u = blockIdx.x; u < 16 * 23; u += gridDim.x) convT_unit_fp8(a.in[I_WIN], INW, a.ws + WS_WTIN8, DM, (u & 15) * 128, (u >> 4) * 256, 1, lds);
    j = ConvJob{a.in[I_WOUT], DM, (bf16_t*)(a.ws + WS_WTOUT), DM, DM, 0}; run_conv_job(j, blockIdx.x, gridDim.x, lds);
    j = ConvJob{a.in[I_W1K], CMPH, (bf16_t*)(a.ws + WS_W1T), 4096, CMPH, 0}; run_conv_job(j, blockIdx.x, gridDim.x, lds);
    j = ConvJob{a.in[I_W1V], CMPH, (bf16_t*)(a.ws + WS_W1T) + (size_t)CMPH * 4096, 4096, CMPH, 0}; run_conv_job(j, blockIdx.x, gridDim.x, lds);
}
#ifndef CONV_NCT
#define CONV_NCT 768
#endif
constexpr int CONV_UNITS = NEXP * 384, CONV_B = 16;
constexpr int CONV_PRE = 5, CONV_PRE_UNITS = 128 * CONV_PRE;
#ifndef CONV_GLA_UNITS
#define CONV_GLA_UNITS 2048
#endif
constexpr int CONV_GLA_BASE = CONV_UNITS - CONV_GLA_UNITS;
static_assert(CONV_GLA_UNITS == 0 || CONV_GLA_UNITS == 2048, "one conversion unit per GLA chunk unit, or none");
static_assert((CONV_NCT * CONV_B - CONV_PRE_UNITS - 2048) % CONV_B == 0 && (CONV_NCT * CONV_B - 2048) % CONV_B == 0, "the tickets between the pre-converted units and the GLA-hosted units are whole");
static_assert(CONV_NCT <= 1024 && CONV_NCT * CONV_B <= CONV_UNITS, "conversion tickets interleave with the 1024 attention units");
struct ConvU { const float* src; unsigned char* dst; int ld, K, k0, n0, mode; };
__device__ __forceinline__ ConvU conv_moe_desc(const Args& a, int u) {
    const int e = u / 384, r = u % 384; ConvU c;
    if (r < 256) { c.src = a.in[I_WGU] + (size_t)e * DM * 4096; c.ld = 4096; c.dst = a.ws + WS_WTGU + (size_t)e * 4096 * DM; c.K = DM; c.k0 = (r & 15) * 128; c.n0 = (r >> 4) * 256; c.mode = 2; }
    else { const int r2 = r - 256; c.src = a.in[I_WDN] + (size_t)e * DFF * DM; c.ld = DM; c.dst = a.ws + WS_WTDN + (size_t)e * DM * DFF; c.K = DFF; c.k0 = (r2 & 15) * 128; c.n0 = (r2 >> 4) * 256; c.mode = 0; }
    return c;
}
__device__ __forceinline__ void conv_moe_load(f32x4 (&v)[16], const ConvU& c, bool valid) {
    const int tid = TIDX(), l = tid & 63, r = tid >> 6;
    const float* p = c.src + (size_t)(c.k0 + 16 * r) * c.ld + map_col4(c.mode, c.n0 + 4 * l);
    const size_t st = valid ? (size_t)c.ld : 0;
#pragma unroll
    for (int i = 0; i < 16; ++i) v[i] = __builtin_nontemporal_load((const f32x4*)(p + (size_t)i * st));
}
__device__ __forceinline__ void conv_moe_store(const f32x4 (&v)[16], const ConvU& c, LAS unsigned char* lds) {
    const int tid = TIDX(), l = tid & 63, r = tid >> 6;
#pragma unroll
    for (int j = 0; j < 4; ++j) { const int n = 4 * l + j;
        u32x4 w; w.x = pack_fp8x4(v[0][j] * WSCALE, v[1][j] * WSCALE, v[2][j] * WSCALE, v[3][j] * WSCALE); w.y = pack_fp8x4(v[4][j] * WSCALE, v[5][j] * WSCALE, v[6][j] * WSCALE, v[7][j] * WSCALE);
        w.z = pack_fp8x4(v[8][j] * WSCALE, v[9][j] * WSCALE, v[10][j] * WSCALE, v[11][j] * WSCALE); w.w = pack_fp8x4(v[12][j] * WSCALE, v[13][j] * WSCALE, v[14][j] * WSCALE, v[15][j] * WSCALE);
        *(LAS u32x4*)(lds + n * 128 + ((r ^ ((n >> 2) & 7)) << 4)) = w; }
    __syncthreads();
#pragma unroll
    for (int j = 0; j < 4; ++j) { const int n = (tid >> 3) + 64 * j, kc = tid & 7;
        const u32x4 w = *(const LAS u32x4*)(lds + n * 128 + ((kc ^ ((n >> 2) & 7)) << 4));
        *(u32x4*)(c.dst + (size_t)(c.n0 + n) * c.K + c.k0 + 16 * kc) = w; }
    __syncthreads();
}
__device__ __forceinline__ void conv_moe_run(const Args& a, LAS unsigned char* lds, int ubeg, int ustride, int n) {
    if (n <= 0) return;
    f32x4 b0[16], b1[16], b2[16];
    ConvU c0 = conv_moe_desc(a, ubeg), c1 = conv_moe_desc(a, ubeg + (n > 1 ? ustride : 0));
    conv_moe_load(b0, c0, true); conv_moe_load(b1, c1, n > 1);
#pragma unroll 1
    for (int k = 0; k < n; k += 3) {
        const ConvU c2 = conv_moe_desc(a, ubeg + (k + 2 < n ? k + 2 : n - 1) * ustride); conv_moe_load(b2, c2, k + 2 < n);
        conv_moe_store(b0, c0, lds);
        c0 = conv_moe_desc(a, ubeg + (k + 3 < n ? k + 3 : n - 1) * ustride); conv_moe_load(b0, c0, k + 3 < n);
        if (k + 1 < n) conv_moe_store(b1, c1, lds);
        c1 = conv_moe_desc(a, ubeg + (k + 4 < n ? k + 4 : n - 1) * ustride); conv_moe_load(b1, c1, k + 4 < n);
        if (k + 2 < n) conv_moe_store(b2, c2, lds);
    }
}
__device__ __forceinline__ void phase_conv_moe(const Args& a, LAS unsigned char* lds, int u0, int ustride) {
    const int first = CONV_NCT * CONV_B + u0; if (first < CONV_UNITS) conv_moe_run(a, lds, first, ustride, (CONV_UNITS - first + ustride - 1) / ustride);
}

__device__ __forceinline__ void phase_h1(const Args& a) {
    const float* x = a.in[I_X]; const float* mod = (const float*)(a.ws + WS_MOD); bf16_t* h = (bf16_t*)(a.ws + WS_H); unsigned char* h8 = a.ws + WS_H8;
    { int* stok = (int*)(a.ws + WS_STOK); for (int i = blockIdx.x * NT + TIDX(); i < NSLOT_MAX; i += gridDim.x * NT) stok[i] = 0; }
    const size_t n8 = (size_t)NTOK * DM / 8, stride = (size_t)gridDim.x * NT;
    const int nper = (n8 % (4 * stride) == 0) ? 4 : 1;
    for (size_t i0 = (size_t)blockIdx.x * NT + TIDX(); i0 < n8; i0 += nper * stride) {
        f32x4 xa[4], xb[4], sa[4], sb[4], ha[4], hb[4];
#pragma unroll
        for (int k = 0; k < 4; ++k) if (k < nper) { const size_t e0 = (i0 + k * stride) * 8; const int row = (int)(e0 / DM), col = (int)(e0 % DM), b = row / SEQ;
            const float* mb = mod + (size_t)b * 6 * DM;
            xa[k] = *(const f32x4*)(x + e0); xb[k] = *(const f32x4*)(x + e0 + 4); sa[k] = *(const f32x4*)(mb + DM + col); sb[k] = *(const f32x4*)(mb + DM + col + 4);
            ha[k] = *(const f32x4*)(mb + col); hb[k] = *(const f32x4*)(mb + col + 4); }
#pragma unroll
        for (int k = 0; k < 4; ++k) if (k < nper) { const size_t e0 = (i0 + k * stride) * 8;
            const f32x4 r0 = xa[k] * (sa[k] + 1.0f) + ha[k], r1 = xb[k] * (sb[k] + 1.0f) + hb[k];
            u32x4 w; w.x = cvt_pk_bf16(r0[0], r0[1]); w.y = cvt_pk_bf16(r0[2], r0[3]); w.z = cvt_pk_bf16(r1[0], r1[1]); w.w = cvt_pk_bf16(r1[2], r1[3]);
            if (IN_BF16_TILES) *(u32x4*)(h + e0) = w;
            if (IN_FP8_TILES) { u32x2 w8; w8.x = pack_fp8x4(r0[0], r0[1], r0[2], r0[3]); w8.y = pack_fp8x4(r1[0], r1[1], r1[2], r1[3]); *(u32x2*)(h8 + e0) = w8; } }
    }
}

template <bool DUMMY>
__device__ __forceinline__ void phase_ln1_router(const Args& a, LAS unsigned char* lds) {
    const int tid = TIDX(), wid = tid >> 6, lane = tid & 63;
    const float* xin = a.in[I_X]; const bf16_t* yg = (const bf16_t*)(a.ws + WS_U1) + 2048;
    unsigned char* h2 = a.ws + (DUMMY ? WS_XBUF : WS_H);
    bf16_t* x1o = (bf16_t*)(a.ws + (DUMMY ? WS_SLOC : WS_U1));
    const float* mod = (const float*)(a.ws + WS_MOD);
    const float* g = a.in[I_LN1G]; const float* bt = a.in[I_LN1B]; const float* wr_ = a.in[I_WR]; const float* br = a.in[I_BR];
    int* topi = (int*)(a.ws + (DUMMY ? WS_ACT : WS_TOPI)); float* topw = (float*)(a.ws + (DUMMY ? WS_ACT + (1u << 20) : WS_TOPW)); int* cnt = (int*)(a.ws + WS_CTL + CW_CNT + (DUMMY ? 4096 : 0));
    LAS float* hs = (LAS float*)lds;
    LAS float* part = (LAS float*)(lds + 65536);
    LAS float* lg = (LAS float*)(lds + 65536 + 32768);
    LAS int* hist = (LAS int*)(lds + 65536 + 32768 + 1024);
    LAS float* prm = (LAS float*)(lds + 65536 + 32768 + 4096);
    int bcur = -1;
    if (tid < 32) { hist[tid] = 0; lg[320 + tid] = br[tid]; }
    const int e = tid & 31, ep = tid & 15, ks = tid >> 4;
    f32x2 w0[32], w1[32];
#pragma unroll
    for (int i = 0; i < 32; ++i) { const float* wp = wr_ + (size_t)(ks * 64 + 2 * i) * NEXP + 2 * ep;
        w0[i] = (f32x2){wp[0], wp[NEXP]}; w1[i] = (f32x2){wp[1], wp[NEXP + 1]}; }
    __syncthreads();
    f32x4 v[8]; u32x2 yv[8];
    if ((int)blockIdx.x < NTOK / 8) {
#pragma unroll
        for (int j = 0; j < 8; ++j) { const unsigned r0 = (unsigned)(blockIdx.x * 8 + wid) * 8192u;
            v[j] = *(const f32x4*)((const char*)xin + (size_t)(r0 + j * 1024 + lane * 16)); yv[j] = *(const u32x2*)((const char*)yg + (size_t)(r0 + j * 512 + lane * 8)); } }
    for (int grp = blockIdx.x; grp < NTOK / 8; grp += gridDim.x) {
        int row = grp * 8 + wid; asm volatile("" : "+v"(row));
        const int b = (grp * 8) / SEQ;
        const float* mb = mod + (size_t)b * 6 * DM;
        if (b != bcur) {
            float t0[DM / NT], t1[DM / NT], t2[DM / NT], t3[DM / NT];
#pragma unroll
            for (int k = 0; k < DM / NT; ++k) { const int i = tid + k * NT; t0[k] = g[i]; t1[k] = bt[i]; t2[k] = mb[4 * DM + i]; t3[k] = mb[3 * DM + i]; }
#pragma unroll
            for (int k = 0; k < DM / NT; ++k) { const int i = tid + k * NT; prm[i] = t0[k]; prm[DM + i] = t1[k]; prm[2 * DM + i] = t2[k] + 1.0f; prm[3 * DM + i] = t3[k]; }
            bcur = b; __syncthreads(); }
        unsigned pb = (unsigned)(uintptr_t)prm + (unsigned)lane * 16u;
        asm volatile("" : "+v"(pb));
        const LAS char* pbase = (const LAS char*)(uintptr_t)pb;
        float s = 0.f;
#pragma unroll
        for (int j = 0; j < 8; ++j) { const u32x2 y = yv[j];
            v[j] = v[j] * DN_ALPHA + (f32x4){__uint_as_float(y.x << 16), __uint_as_float(y.x & 0xffff0000u), __uint_as_float(y.y << 16), __uint_as_float(y.y & 0xffff0000u)}; }
#pragma unroll
        for (int j = 0; j < 8; ++j) s += v[j][0] + v[j][1] + v[j][2] + v[j][3];
        const float mu = wave_sum(s) * (1.0f / DM);
        float q = 0.f;
#pragma unroll
        for (int j = 0; j < 8; ++j) { const f32x4 d = v[j] - mu; q += d[0] * d[0] + d[1] * d[1] + d[2] * d[2] + d[3] * d[3]; }
        const float rstd = rsqrtf(wave_sum(q) * (1.0f / DM) + LN_EPS);
#pragma unroll
        for (int j = 0; j < 8; ++j) { const int col = j * 256 + lane * 4;
            if ((j & 3) == 0) __builtin_amdgcn_sched_barrier(0);
            const f32x4 x1 = (v[j] - mu) * rstd * *(const LAS f32x4*)(pbase + j * 1024) + *(const LAS f32x4*)(pbase + j * 1024 + 8192);
            { u32x2 xw; xw.x = cvt_pk_bf16(x1[0], x1[1]); xw.y = cvt_pk_bf16(x1[2], x1[3]); *(u32x2*)((char*)x1o + (size_t)((unsigned)row * 8192u + j * 512 + lane * 8)) = xw; }
            const f32x4 hh = x1 * *(const LAS f32x4*)(pbase + j * 1024 + 16384) + *(const LAS f32x4*)(pbase + j * 1024 + 24576);
            *(unsigned*)(h2 + (size_t)((unsigned)row * 2048u + j * 256 + lane * 4)) = pack_fp8x4(hh[0], hh[1], hh[2], hh[3]);
            *(LAS f32x4*)(hs + wid * DM + col) = hh; }
        if (grp + (int)gridDim.x < NTOK / 8) {
#pragma unroll
            for (int j = 0; j < 8; ++j) { const unsigned rn = (unsigned)(row + (int)gridDim.x * 8) * 8192u; v[j] = *(const f32x4*)((const char*)xin + (size_t)(rn + j * 1024 + lane * 16)); yv[j] = *(const u32x2*)((const char*)yg + (size_t)(rn + j * 512 + lane * 8)); } }
        __syncthreads();
#pragma unroll 1
        for (int r = 0; r < 8; ++r) {
            unsigned hb_ = (unsigned)(uintptr_t)(hs + r * DM + ks * 64); asm volatile("" : "+v"(hb_));
            const LAS f32x4* hr = (const LAS f32x4*)(uintptr_t)hb_;
            f32x2 a0 = {0.f, 0.f}, a0b = {0.f, 0.f}, a1 = {0.f, 0.f}, a1b = {0.f, 0.f};
            f32x4 hb[2];
#pragma unroll
            for (int i = 0; i < 2; ++i) hb[i] = hr[i];
#pragma unroll
            for (int i = 0; i < 16; ++i) { const f32x4 hv = hb[i & 1];
                const f32x2 hl = {hv[0], hv[1]}, hh2 = {hv[2], hv[3]};
                a0 = __builtin_elementwise_fma(hl, w0[2 * i], a0); a0b = __builtin_elementwise_fma(hh2, w0[2 * i + 1], a0b);
                a1 = __builtin_elementwise_fma(hl, w1[2 * i], a1); a1b = __builtin_elementwise_fma(hh2, w1[2 * i + 1], a1b);
                if (i + 2 < 16) hb[i & 1] = hr[i + 2];
                __builtin_amdgcn_sched_barrier(0); }
            const f32x2 pp = {(a0[0] + a0[1]) + (a0b[0] + a0b[1]), (a1[0] + a1[1]) + (a1b[0] + a1b[1])};
            *(LAS f32x2*)(part + (r * 32 + ks) * 32 + 2 * ep) = pp; }
        __syncthreads();
        if (tid < 256) { const int t3 = TIDX(), r = t3 >> 5, e = t3 & 31; float sacc = lg[320 + e];
#pragma unroll
            for (int k2 = 0; k2 < 32; ++k2) sacc += part[(r * 32 + k2) * 32 + e];
            lg[r * 32 + e] = sacc;
            asm volatile("s_waitcnt lgkmcnt(0)" ::: "memory");
            int rank = 0;
#pragma unroll
            for (int j = 0; j < 32; ++j) { const float x = lg[r * 32 + j]; rank += (x > sacc || (x == sacc && j < e)) ? 1 : 0; }
            LAS float* tv = lg + 288 + r * 4;
            if (rank < 4) tv[rank] = sacc;
            asm volatile("s_waitcnt lgkmcnt(0)" ::: "memory");
            if (rank < 4) { const float m = tv[0]; const float se = ((1.0f + __expf(tv[1] - m)) + __expf(tv[2] - m)) + __expf(tv[3] - m);
                const int tok = row - wid + r; topi[tok * 4 + rank] = e; topw[tok * 4 + rank] = __expf(sacc - m) / se; atomicAdd((int*)&hist[e], 1); } }
    }
    __syncthreads();
    if (tid < 32) { const int hv = hist[tid]; if (hv) atomicAdd(&cnt[tid], hv); }
}

__device__ __forceinline__ int moe_meta(const Args& a, LAS int* tile_e, LAS int* startp) {
    const int* cnt = (const int*)(a.ws + WS_CTL + CW_CNT);
    const int tid = TIDX();
    if (tid < 64) {
        const int e2 = tid & 31;
        const int c = __hip_atomic_load(&cnt[e2], __ATOMIC_RELAXED, __HIP_MEMORY_SCOPE_AGENT);
        const int nt2 = (c + MOEB - 1) / MOEB;
        int incl = nt2;
#pragma unroll
        for (int of = 1; of < 32; of <<= 1) { const int v = __shfl_up(incl, of, 32); if (e2 >= of) incl += v; }
        const int excl = incl - nt2;
        if (tid < 32) { startp[e2] = excl * MOEB; if (e2 == 31) startp[NEXP] = incl * MOEB;
            for (int t = 0; t < nt2; ++t) tile_e[excl + t] = e2; }
    }
    __syncthreads();
    return startp[NEXP] / MOEB;
}

__device__ __forceinline__ void phase_dispatch(const Args& a, LAS unsigned char* lds) {
    const int tid = TIDX(), wid = tid >> 6, lane = tid & 63;
    LAS int* tile_e = (LAS int*)(lds); LAS int* startp = (LAS int*)(lds + 4096);
    LAS int* hist = (LAS int*)(lds + 8192); LAS int* base = (LAS int*)(lds + 8192 + 256); LAS int* lcnt = (LAS int*)(lds + 8192 + 512);
    LAS int* slots = (LAS int*)(lds + 16384);
    moe_meta(a, tile_e, startp);
    const int* topi = (const int*)(a.ws + WS_TOPI); int* slot_of = (int*)(a.ws + WS_SLOT); int* cur = (int*)(a.ws + WS_CTL + CW_CUR);
    int* stok = (int*)(a.ws + WS_STOK);
    for (int chunk = blockIdx.x; chunk < NTOK / 128; chunk += gridDim.x) {
        if (tid < 32) { hist[tid] = 0; lcnt[tid] = 0; }
        __syncthreads();
        const int aidx = chunk * 512 + tid; const int e = topi[aidx];
        atomicAdd((int*)&hist[e], 1);
        __syncthreads();
        if (tid < 32) base[tid] = hist[tid] ? atomicAdd(&cur[tid], hist[tid]) : 0;
        __syncthreads();
        const int pos = base[e] + atomicAdd((int*)&lcnt[e], 1);
        const int slot = startp[e] + pos;
        slot_of[aidx] = slot;
        stok[slot] = aidx >> 2;
        __syncthreads();
    }
}

__device__ __forceinline__ void phase_combine_ln2(const Args& a, LAS unsigned char* lds) {
    const int tid = TIDX(), wid = tid >> 6, lane = tid & 63;
    const bf16_t* x1 = (const bf16_t*)(a.ws + WS_U1); const bf16_t* yb = (const bf16_t*)(a.ws + WS_XBUF);
    const int* slot_of = (const int*)(a.ws + WS_SLOT); const float* topw = (const float*)(a.ws + WS_TOPW);
    const float* mod = (const float*)(a.ws + WS_MOD); const float* g = a.in[I_LN2G]; const float* bt = a.in[I_LN2B];
    LAS float* prm = (LAS float*)lds;
    { float t0[DM / NT], t1[DM / NT];
#pragma unroll
      for (int k = 0; k < DM / NT; ++k) { t0[k] = g[tid + k * NT]; t1[k] = bt[tid + k * NT]; }
#pragma unroll
      for (int k = 0; k < DM / NT; ++k) { prm[tid + k * NT] = t0[k]; prm[DM + tid + k * NT] = t1[k]; } }
    __syncthreads();
    unsigned pb = (unsigned)(uintptr_t)prm + (unsigned)lane * 16u; asm volatile("" : "+v"(pb));
    const LAS char* pbase = (const LAS char*)(uintptr_t)pb;
    for (int row = blockIdx.x * 8 + wid; row < NTOK; row += gridDim.x * 8) {
        const int b = row / SEQ; const float* g2 = mod + (size_t)b * 6 * DM + 5 * DM;
        int sl[4]; float w[4];
#pragma unroll
        for (int k = 0; k < 4; ++k) { sl[k] = slot_of[row * 4 + k]; w[k] = topw[row * 4 + k]; }
        f32x4 v[8]; float s = 0.f;
#pragma unroll
        for (int j = 0; j < 8; ++j) { const int col = j * 256 + lane * 4;
            f32x4 f = (f32x4){0.f, 0.f, 0.f, 0.f};
#pragma unroll
            for (int k = 0; k < 4; ++k) { const u32x2 y = *(const u32x2*)(yb + (size_t)sl[k] * DM + col);
                f[0] += w[k] * __uint_as_float(y.x << 16); f[1] += w[k] * __uint_as_float(y.x & 0xffff0000u);
                f[2] += w[k] * __uint_as_float(y.y << 16); f[3] += w[k] * __uint_as_float(y.y & 0xffff0000u); }
            const u32x2 xw = *(const u32x2*)(x1 + (size_t)row * (2 * DM) + col);
            const f32x4 xf = {__uint_as_float(xw.x << 16), __uint_as_float(xw.x & 0xffff0000u), __uint_as_float(xw.y << 16), __uint_as_float(xw.y & 0xffff0000u)};
            v[j] = xf * DN_ALPHA + *(const f32x4*)(g2 + col) * f;
            s += v[j][0] + v[j][1] + v[j][2] + v[j][3]; }
        const float mu = wave_sum(s) * (1.0f / DM);
        float q = 0.f;
#pragma unroll
        for (int j = 0; j < 8; ++j) { const f32x4 d = v[j] - mu; q += d[0] * d[0] + d[1] * d[1] + d[2] * d[2] + d[3] * d[3]; }
        const float rstd = rsqrtf(wave_sum(q) * (1.0f / DM) + LN_EPS);
#pragma unroll
        for (int j = 0; j < 8; ++j) { const int col = j * 256 + lane * 4;
            *(f32x4*)(a.out + (size_t)row * DM + col) = (v[j] - mu) * rstd * *(const LAS f32x4*)(pbase + j * 1024) + *(const LAS f32x4*)(pbase + j * 1024 + 8192); }
    }
}
namespace nsa {
constexpr float SCALE = 0.08838834764831845f;
#ifndef NSA_THR
#define NSA_THR 8.f
#endif
constexpr float THR = NSA_THR;
constexpr int SHM_K = 64 * 128 * 2, SHM_V = 64 * 128 * 2;
constexpr int NSLOT = 3, SLOTB = SHM_V + SHM_K;
constexpr int L_V = 0, L_K = SHM_V, L_WS = NSLOT * SLOTB;
constexpr int L_IMP = L_WS + 8 * 64 * 4;
constexpr int IMP_LD = 132;
constexpr int L_SELM = L_IMP + 64 * IMP_LD * 4;
constexpr int L_TL = L_SELM + 64 * 16;
constexpr int L_END = L_TL + 3 * 132 * 4;
#define KSWZ(row, colB) ((row) * 256 + ((colB) ^ (((row) & 7) << 4)))
#define SBAR() __builtin_amdgcn_sched_barrier(0)
__device__ __forceinline__ int v_st(int k, int c) { const int kk = (k & ~0xC) | ((k & 4) << 1) | ((k & 8) >> 1); return ((kk >> 3) * 4 + (c >> 5)) * 512 + ((kk & 7) * 32 + (c & 31)) * 2; }
__device__ __forceinline__ int v_rd_base(int lane) { return ((lane & 3) << 3) | (((lane >> 2) & 3) << 6) | (((lane >> 4) & 1) << 5) | (((lane >> 5) & 1) << 8); }
constexpr int v_rd_off(int d0, int ks, int half) { return d0 * 512 + ks * 4096 + half * 2048; }
__device__ __forceinline__ int crow(int r, int hi) { return (r & 3) + 8 * (r >> 2) + 4 * hi; }
__device__ __forceinline__ unsigned cvtpk(float lo, float hi) { unsigned r; asm volatile("v_cvt_pk_bf16_f32 %0, %1, %2" : "=v"(r) : "v"(lo), "v"(hi)); return r; }

__device__ __forceinline__ void partialSM(f32x16& p0, f32x16& p1, float& m_reg, float& mn, float& alpha) {
    float mx[4] = {p0[0], p0[1], p0[2], p0[3]};
#pragma unroll
    for (int r = 4; r < 16; r += 4) { mx[0] = fmaxf(mx[0], p0[r]); mx[1] = fmaxf(mx[1], p0[r + 1]); mx[2] = fmaxf(mx[2], p0[r + 2]); mx[3] = fmaxf(mx[3], p0[r + 3]); }
#pragma unroll
    for (int r = 0; r < 16; r += 4) { mx[0] = fmaxf(mx[0], p1[r]); mx[1] = fmaxf(mx[1], p1[r + 1]); mx[2] = fmaxf(mx[2], p1[r + 2]); mx[3] = fmaxf(mx[3], p1[r + 3]); }
    float pmax = fmaxf(fmaxf(mx[0], mx[1]), fmaxf(mx[2], mx[3]));
    { auto rr = __builtin_amdgcn_permlane32_swap(__float_as_uint(pmax), __float_as_uint(pmax), false, false);
      pmax = fmaxf(__uint_as_float(rr[0]), __uint_as_float(rr[1])); }
    constexpr float C2 = 1.4426950408889634f * SCALE;
    if (__builtin_expect(__all((pmax - m_reg) * SCALE <= THR), 1)) { mn = m_reg; alpha = 1.f; }
    else { mn = fmaxf(m_reg, pmax); alpha = __builtin_amdgcn_exp2f((m_reg - mn) * C2); m_reg = mn; }
    const float mnL = -mn * C2;
    for (int r = 0; r < 16; ++r) p0[r] = fmaf(p0[r], C2, mnL); for (int r = 0; r < 16; ++r) p1[r] = fmaf(p1[r], C2, mnL);
    for (int r = 0; r < 16; ++r) p0[r] = __builtin_amdgcn_exp2f(p0[r]);
}
constexpr float THR2 = THR * 1.4426950408889634f;
__device__ __forceinline__ void partialSM2(f32x16& p0, f32x16& p1, float& m_reg, float& alpha) {
    float mx[4] = {p0[0], p0[1], p0[2], p0[3]};
#pragma unroll
    for (int r = 4; r < 16; r += 4) { mx[0] = fmaxf(mx[0], p0[r]); mx[1] = fmaxf(mx[1], p0[r + 1]); mx[2] = fmaxf(mx[2], p0[r + 2]); mx[3] = fmaxf(mx[3], p0[r + 3]); }
#pragma unroll
    for (int r = 0; r < 16; r += 4) { mx[0] = fmaxf(mx[0], p1[r]); mx[1] = fmaxf(mx[1], p1[r + 1]); mx[2] = fmaxf(mx[2], p1[r + 2]); mx[3] = fmaxf(mx[3], p1[r + 3]); }
    float pmax = fmaxf(fmaxf(mx[0], mx[1]), fmaxf(mx[2], mx[3]));
    { auto rr = __builtin_amdgcn_permlane32_swap(__float_as_uint(pmax), __float_as_uint(pmax), false, false);
      pmax = fmaxf(__uint_as_float(rr[0]), __uint_as_float(rr[1])); }
    const float NINF = -__builtin_inff();
    const bool valid = m_reg != NINF;
    const bool need = valid ? (pmax > THR2) : (pmax != NINF);
    alpha = 1.f;
    if (__builtin_expect(__any(need), 0)) {
        const float d = need ? pmax : 0.f;
        alpha = (valid && need) ? __builtin_amdgcn_exp2f(-d) : 1.f;
        m_reg = need ? (valid ? m_reg + d : d) : m_reg;
        for (int r = 0; r < 16; ++r) { p0[r] -= d; p1[r] -= d; }
    }
    for (int r = 0; r < 16; ++r) p0[r] = __builtin_amdgcn_exp2f(p0[r]);
}
#define PK4(P, B_, OUT) do { unsigned a0 = cvtpk(P[B_+0], P[B_+1]), a1 = cvtpk(P[B_+2], P[B_+3]);                          \
        unsigned b0 = cvtpk(P[B_+4], P[B_+5]), b1 = cvtpk(P[B_+6], P[B_+7]);                                             \
        auto r0 = __builtin_amdgcn_permlane32_swap(a0, b0, false, false); auto r1 = __builtin_amdgcn_permlane32_swap(a1, b1, false, false); \
        u32x4 w = {r0[0], r1[0], r0[1], r1[1]}; OUT = *reinterpret_cast<bf16x8*>(&w); } while (0)
__device__ __forceinline__ void finishSM(f32x16& p0, f32x16& p1, float alpha, float& l_reg, bf16x8& pa0, bf16x8& pa1, bf16x8& pa2, bf16x8& pa3) {
    for (int r = 0; r < 16; ++r) p1[r] = __builtin_amdgcn_exp2f(p1[r]);
    float sx[4] = {p0[0], p0[1], p0[2], p0[3]};
#pragma unroll
    for (int r = 4; r < 16; r += 4) { sx[0] += p0[r]; sx[1] += p0[r + 1]; sx[2] += p0[r + 2]; sx[3] += p0[r + 3]; }
#pragma unroll
    for (int r = 0; r < 16; r += 4) { sx[0] += p1[r]; sx[1] += p1[r + 1]; sx[2] += p1[r + 2]; sx[3] += p1[r + 3]; }
    float ps = (sx[0] + sx[1]) + (sx[2] + sx[3]);
    { auto rr = __builtin_amdgcn_permlane32_swap(__float_as_uint(ps), __float_as_uint(ps), false, false);
      ps = __uint_as_float(rr[0]) + __uint_as_float(rr[1]); }
    l_reg = l_reg * alpha + ps;
    PK4(p0, 0, pa0); PK4(p0, 8, pa1); PK4(p1, 0, pa2); PK4(p1, 8, pa3);
}
__device__ __forceinline__ void qkt(f32x16& p0, f32x16& p1, const LAS char* Kimg, int r32, int hi, const bf16x8* qr) {
    p0 = f32x16{}; p1 = f32x16{};
    const LAS char* kb[4];
#pragma unroll
    for (int dd = 0; dd < 4; ++dd) kb[dd] = Kimg + KSWZ(r32, (dd * 16 + hi * 8) * 2);
#pragma unroll
    for (int d0 = 0; d0 < 8; ++d0) { const LAS char* a = kb[d0 & 3] + (d0 >> 2) * 128;
        bf16x8 b0 = *reinterpret_cast<const LAS bf16x8*>(a);
        bf16x8 b1 = *reinterpret_cast<const LAS bf16x8*>(a + 32 * 256);
        p0 = __builtin_amdgcn_mfma_f32_32x32x16_bf16(b0, qr[d0], p0, 0, 0, 0);
        p1 = __builtin_amdgcn_mfma_f32_32x32x16_bf16(b1, qr[d0], p1, 0, 0, 0); }
}
__device__ __forceinline__ void pv_tile(f32x16* o, int vbase, bf16x8 pa0, bf16x8 pa1, bf16x8 pa2, bf16x8 pa3) {
#define TRRD(dst, off) asm volatile("ds_read_b64_tr_b16 %0, %1 offset:%2" : "=&v"(dst) : "v"(vbase), "i"(off) : "memory")
#define PV_RD(S, d0) do { constexpr int b_ = v_rd_off(d0, 0, 0); \
        TRRD(S[0], b_); TRRD(S[4], b_ + 2048); TRRD(S[1], b_ + 4096); TRRD(S[5], b_ + 6144); TRRD(S[2], b_ + 8192); TRRD(S[6], b_ + 10240); TRRD(S[3], b_ + 12288); TRRD(S[7], b_ + 14336); } while (0)
#define PV_MM(S, d0) do { \
        o[d0] = __builtin_amdgcn_mfma_f32_32x32x16_bf16(pa0, (bf16x8){S[0][0], S[0][1], S[0][2], S[0][3], S[4][0], S[4][1], S[4][2], S[4][3]}, o[d0], 0, 0, 0);   \
        o[d0] = __builtin_amdgcn_mfma_f32_32x32x16_bf16(pa1, (bf16x8){S[1][0], S[1][1], S[1][2], S[1][3], S[5][0], S[5][1], S[5][2], S[5][3]}, o[d0], 0, 0, 0);   \
        o[d0] = __builtin_amdgcn_mfma_f32_32x32x16_bf16(pa2, (bf16x8){S[2][0], S[2][1], S[2][2], S[2][3], S[6][0], S[6][1], S[6][2], S[6][3]}, o[d0], 0, 0, 0);   \
        o[d0] = __builtin_amdgcn_mfma_f32_32x32x16_bf16(pa3, (bf16x8){S[3][0], S[3][1], S[3][2], S[3][3], S[7][0], S[7][1], S[7][2], S[7][3]}, o[d0], 0, 0, 0); } while (0)
    s16x4 A_[8], B_[8];
    PV_RD(A_, 0);
    PV_RD(B_, 1); asm volatile("s_waitcnt lgkmcnt(8)" : "+v"(A_[0]), "+v"(A_[1]), "+v"(A_[2]), "+v"(A_[3]), "+v"(A_[4]), "+v"(A_[5]), "+v"(A_[6]), "+v"(A_[7]) :: "memory"); SBAR(); PV_MM(A_, 0); SBAR();
    PV_RD(A_, 2); asm volatile("s_waitcnt lgkmcnt(8)" : "+v"(B_[0]), "+v"(B_[1]), "+v"(B_[2]), "+v"(B_[3]), "+v"(B_[4]), "+v"(B_[5]), "+v"(B_[6]), "+v"(B_[7]) :: "memory"); SBAR(); PV_MM(B_, 1); SBAR();
    PV_RD(B_, 3); asm volatile("s_waitcnt lgkmcnt(8)" : "+v"(A_[0]), "+v"(A_[1]), "+v"(A_[2]), "+v"(A_[3]), "+v"(A_[4]), "+v"(A_[5]), "+v"(A_[6]), "+v"(A_[7]) :: "memory"); SBAR(); PV_MM(A_, 2); SBAR();
    asm volatile("s_waitcnt lgkmcnt(0)" : "+v"(B_[0]), "+v"(B_[1]), "+v"(B_[2]), "+v"(B_[3]), "+v"(B_[4]), "+v"(B_[5]), "+v"(B_[6]), "+v"(B_[7]) :: "memory"); SBAR(); PV_MM(B_, 3);
#undef PV_MM
#undef PV_RD
#undef TRRD
}

template <int BR>
__device__ __forceinline__ void bias_mask(f32x16& p0, f32x16& p1, int pos, int krow0, int hi, float nslopeS, bool selected, bool need_mask) {
    const float NEG = -__builtin_inff();
    if (BR == 0) {
        const int dq = pos - 16 * (krow0 + 4 * hi);
        const float base = ((float)dq - 15.5f) * nslopeS;
        if (need_mask) {
#pragma unroll
            for (int r = 0; r < 16; ++r) { const int c = (r & 3) + 8 * (r >> 2);
                const float b0 = fmaf((float)(-16 * c), nslopeS, base), b1 = fmaf((float)(-16 * c - 512), nslopeS, base);
                p0[r] = (dq - 16 * c >= 31) ? p0[r] + b0 : NEG;
                p1[r] = (dq - 16 * c - 512 >= 31) ? p1[r] + b1 : NEG; }
        } else {
#pragma unroll
            for (int r = 0; r < 16; ++r) { const int c = (r & 3) + 8 * (r >> 2);
                p0[r] += fmaf((float)(-16 * c), nslopeS, base); p1[r] += fmaf((float)(-16 * c - 512), nslopeS, base); }
        }
    } else {
        const int dq = pos - krow0 - 4 * hi;
        float base = (float)dq * nslopeS;
        if (BR == 1 && !selected) base = NEG;
        if (need_mask) {
#pragma unroll
            for (int r = 0; r < 16; ++r) { const int c = (r & 3) + 8 * (r >> 2);
                const float b0 = fmaf((float)(-c), nslopeS, base), b1 = fmaf((float)(-c - 32), nslopeS, base);
                bool v0, v1;
                if (BR == 1) { v0 = (dq - c >= 0); v1 = (dq - c - 32 >= 0); }
                else { v0 = (unsigned)(dq - c) < (unsigned)WIN; v1 = (unsigned)(dq - c - 32) < (unsigned)WIN; }
                p0[r] = v0 ? p0[r] + b0 : NEG; p1[r] = v1 ? p1[r] + b1 : NEG; }
        } else {
#pragma unroll
            for (int r = 0; r < 16; ++r) { const int c = (r & 3) + 8 * (r >> 2);
                p0[r] += fmaf((float)(-c), nslopeS, base); p1[r] += fmaf((float)(-c - 32), nslopeS, base); }
        }
    }
}

__device__ __forceinline__ void qkt_acc(f32x16& p0, f32x16& p1, const LAS char* Kimg, int r32, int hi, const bf16x8* qr) {
    const LAS char* kb[4];
#pragma unroll
    for (int dd = 0; dd < 4; ++dd) kb[dd] = Kimg + KSWZ(r32, (dd * 16 + hi * 8) * 2);
    bf16x8 f0[3], f1[3];
#pragma unroll
    for (int d0 = 0; d0 < 2; ++d0) { const LAS char* a = kb[d0 & 3] + (d0 >> 2) * 128; f0[d0] = *reinterpret_cast<const LAS bf16x8*>(a); f1[d0] = *reinterpret_cast<const LAS bf16x8*>(a + 32 * 256); }
#pragma unroll
    for (int d0 = 0; d0 < 8; ++d0) {
        if (d0 + 2 < 8) { const LAS char* a = kb[(d0 + 2) & 3] + ((d0 + 2) >> 2) * 128; f0[(d0 + 2) % 3] = *reinterpret_cast<const LAS bf16x8*>(a); f1[(d0 + 2) % 3] = *reinterpret_cast<const LAS bf16x8*>(a + 32 * 256); }
        SBAR();
        p0 = __builtin_amdgcn_mfma_f32_32x32x16_bf16(f0[d0 % 3], qr[d0], p0, 0, 0, 0);
        p1 = __builtin_amdgcn_mfma_f32_32x32x16_bf16(f1[d0 % 3], qr[d0], p1, 0, 0, 0);
        SBAR(); }
}
template <int BR>
__device__ __forceinline__ void bias_init(f32x16& p0, f32x16& p1, int pos, int krow0, int hi, float nslopeS, bool selected, float shift) {
    if (BR == 0) {
        const int dq = pos - 16 * (krow0 + 4 * hi);
        const float base = fmaf((float)dq - 15.5f, nslopeS, -shift);
#pragma unroll
        for (int r = 0; r < 16; ++r) { const int c = (r & 3) + 8 * (r >> 2);
            p0[r] = fmaf((float)(-16 * c), nslopeS, base); p1[r] = fmaf((float)(-16 * c - 512), nslopeS, base); }
    } else {
        const int dq = pos - krow0 - 4 * hi;
        float base = fmaf((float)dq, nslopeS, -shift);
        if (BR == 1 && !selected) base = -__builtin_inff();
#pragma unroll
        for (int r = 0; r < 16; ++r) { const int c = (r & 3) + 8 * (r >> 2);
            p0[r] = fmaf((float)(-c), nslopeS, base); p1[r] = fmaf((float)(-c - 32), nslopeS, base); }
    }
}
template <int BR>
__device__ __forceinline__ void mask_only(f32x16& p0, f32x16& p1, int pos, int krow0, int hi) {
    const float NEG = -__builtin_inff();
    if (BR == 0) {
        const int dq = pos - 16 * (krow0 + 4 * hi);
#pragma unroll
        for (int r = 0; r < 16; ++r) { const int c = (r & 3) + 8 * (r >> 2);
            p0[r] = (dq - 16 * c >= 31) ? p0[r] : NEG; p1[r] = (dq - 16 * c - 512 >= 31) ? p1[r] : NEG; }
    } else {
        const int dq = pos - krow0 - 4 * hi;
#pragma unroll
        for (int r = 0; r < 16; ++r) { const int c = (r & 3) + 8 * (r >> 2);
            bool v0, v1;
            if (BR == 1) { v0 = (dq - c >= 0); v1 = (dq - c - 32 >= 0); }
            else { v0 = (unsigned)(dq - c) < (unsigned)WIN; v1 = (unsigned)(dq - c - 32) < (unsigned)WIN; }
            p0[r] = v0 ? p0[r] : NEG; p1[r] = v1 ? p1[r] : NEG; }
    }
}

__device__ __forceinline__ void lds_add(LAS float* p, float v) { asm volatile("ds_add_f32 %0, %1" :: "v"((unsigned)(uintptr_t)p), "v"(v) : "memory"); }
struct Ctx {
    LAS char* lds; int tid, wid, lane, r32, hi;
    int vb0;
    LAS float* wsf;
};
__device__ __forceinline__ void glds_tile(const Ctx& c, const bf16_t* Kp, const bf16_t* Vp, size_t ld, int krow0, int slot) {
#pragma unroll
    for (int i = 0; i < 2; ++i) { const int p = c.tid * 16 + i * 8192;
        const int row = p >> 8, ch = ((p >> 4) & 15) ^ (row & 7);
        const int st = p >> 9, kk = (st >> 2) * 8 + ((p >> 6) & 7), k = (kk & ~0xC) | ((kk & 4) << 1) | ((kk & 8) >> 1), col = (st & 3) * 32 + ((p >> 4) & 3) * 8;
        __builtin_amdgcn_global_load_lds((const unsigned*)(Vp + (size_t)(krow0 + k) * ld + col), (LAS unsigned*)(c.lds + slot * SLOTB + L_V + c.wid * 1024 + i * 8192), 16, 0, 0);
        __builtin_amdgcn_global_load_lds((const unsigned*)(Kp + (size_t)(krow0 + row) * ld + ch * 8), (LAS unsigned*)(c.lds + slot * SLOTB + L_K + c.wid * 1024 + i * 8192), 16, 0, 0); }
}
__device__ __forceinline__ void rescale_rows(f32x16* o, float f, const Ctx& c) {
    if (c.hi == 0) c.wsf[c.r32] = f;
    asm volatile("s_waitcnt lgkmcnt(0)" ::: "memory");
#pragma unroll
    for (int r = 0; r < 16; ++r) { const float fr = c.wsf[crow(r, c.hi)];
#pragma unroll
        for (int d = 0; d < 4; ++d) o[d][r] *= fr; }
}

template <int STEP>
__device__ __forceinline__ void accum_rows(f32x16* o, float f, const Ctx& c, float* scr, bf16_t* cat, size_t tok0, int g) {
    if (c.hi == 0) c.wsf[c.r32] = f;
    int lofs = c.hi * 4096 + g * 512 + c.r32;
    asm volatile("" : "+v"(lofs));
    unsigned sofs = ((unsigned)(tok0 >> 6) * 2u + (unsigned)g) * 32768u + (unsigned)c.wid * 4096u + (unsigned)c.lane * 4u;
    asm volatile("" : "+v"(sofs));
    asm volatile("s_waitcnt lgkmcnt(0)" ::: "memory");
    float* sb = scr + sofs;
    bf16_t* cb = cat + tok0 * DM + (lofs + c.hi * 4096);
    if (STEP > 0) {
        f32x4 t[16];
#pragma unroll
        for (int i4 = 0; i4 < 16; ++i4) t[i4] = *(const f32x4*)(sb + i4 * 256);
#pragma unroll
        for (int r = 0; r < 16; ++r) { const float fr = c.wsf[crow(r, c.hi)];
#pragma unroll
            for (int d0 = 0; d0 < 4; ++d0) o[d0][r] = fmaf(o[d0][r], fr, t[d0 * 4 + (r >> 2)][r & 3]); }
    } else {
#pragma unroll
        for (int r = 0; r < 16; ++r) { const float fr = c.wsf[crow(r, c.hi)];
#pragma unroll
            for (int d0 = 0; d0 < 4; ++d0) o[d0][r] *= fr; }
    }
    if (STEP < 2) {
#pragma unroll
        for (int d0 = 0; d0 < 4; ++d0)
#pragma unroll
            for (int k = 0; k < 4; ++k) *(f32x4*)(sb + (d0 * 4 + k) * 256) = (f32x4){o[d0][4 * k], o[d0][4 * k + 1], o[d0][4 * k + 2], o[d0][4 * k + 3]};
    } else {
#pragma unroll
        for (int r = 0; r < 16; ++r)
#pragma unroll
            for (int d0 = 0; d0 < 4; ++d0) { const float v = o[d0][r];
                const float vn = __int_as_float(__builtin_amdgcn_update_dpp(0, __float_as_int(v), 0xB1  , 0xf, 0xf, false));
                if ((c.r32 & 1) == 0) *(unsigned*)(cb + (r & 3) * DM + (r >> 2) * 128 + d0 * 32) = cvtpk(v, vn); }
    }
#pragma unroll
    for (int r = 0; r < 16; ++r)
#pragma unroll
        for (int d0 = 0; d0 < 4; ++d0) o[d0][r] = 0.f;
}

struct Chain { const bf16_t* Kp; const bf16_t* Vp; size_t ld; const LAS int* tl; int nt; };
template <int BR, int MODE>
__device__ __forceinline__ bool attn_pass(const Ctx& c, const bf16x8* qr, const bf16_t* Kp, const bf16_t* Vp, size_t ld, const LAS int* tl, int nt,
                                          int pos, float nslopeS, const u32x4 selw, float& m_reg, float& l_reg, f32x16* o, LAS float* impq, bool pre, int& slot, const Chain nx, int pflag = 0) {
    if (nt <= 0) return false;
    constexpr float C2 = 1.4426950408889634f * SCALE;
    if (!pre) {
        asm volatile("s_waitcnt vmcnt(0) lgkmcnt(0)" ::: "memory");
        __builtin_amdgcn_s_barrier();
        glds_tile(c, Kp, Vp, ld, tl[0], 0);
        if (nt > 1) glds_tile(c, Kp, Vp, ld, tl[1], 1);
        slot = 0; }
    for (int t = 0; t < nt; ++t) {
        if (t + 1 < nt) asm volatile("s_waitcnt vmcnt(4)" ::: "memory"); else asm volatile("s_waitcnt vmcnt(0)" ::: "memory");
        __builtin_amdgcn_s_barrier();
        if (t + 2 < nt) glds_tile(c, Kp, Vp, ld, tl[t + 2], slot == 0 ? 2 : slot - 1);
        const int krow0 = tl[t];
        const LAS char* Kimg = c.lds + slot * SLOTB + L_K; const int vbase = c.vb0 + slot * SLOTB;
        bool selected = true, need_mask;
        const int pmin = pos - (c.r32 & 7);
        if (BR == 0) need_mask = (krow0 + 63) * 16 + 31 > __builtin_amdgcn_readfirstlane(pmin);
        else if (BR == 1) { const int blk = krow0 >> 6, wsel = blk >> 5; const unsigned ww = wsel == 0 ? selw.x : (wsel == 1 ? selw.y : (wsel == 2 ? selw.z : selw.w)); selected = (ww >> (blk & 31)) & 1u;
                            need_mask = krow0 + 63 > __builtin_amdgcn_readfirstlane(pmin); }
        else need_mask = (krow0 + 63 > __builtin_amdgcn_readfirstlane(pmin)) || (krow0 < __builtin_amdgcn_readfirstlane(pmin) + 7 - (WIN - 1));
        f32x16 p0, p1;
        bias_init<BR>(p0, p1, pos, krow0, c.hi, nslopeS, selected, m_reg != -__builtin_inff() ? m_reg : 0.f);
        SBAR(); qkt_acc(p0, p1, Kimg, c.r32, c.hi, qr);
        if (need_mask) mask_only<BR>(p0, p1, pos, krow0, c.hi);
        if (MODE == 2) {
#pragma unroll
            for (int r = 0; r < 16; ++r) { p0[r] = __builtin_amdgcn_exp2f(p0[r]) * l_reg; p1[r] = __builtin_amdgcn_exp2f(p1[r]) * l_reg; }
            if (!(PROBE_DUP == 14 && pflag)) { const int c4 = (krow0 >> 2) + c.hi;
              float W[16];
#pragma unroll
              for (int k = 0; k < 4; ++k) { W[2 * k] = (p0[4 * k] + p0[4 * k + 1]) + (p0[4 * k + 2] + p0[4 * k + 3]); W[2 * k + 1] = p0[4 * k + 3];
                  W[8 + 2 * k] = (p1[4 * k] + p1[4 * k + 1]) + (p1[4 * k + 2] + p1[4 * k + 3]); W[8 + 2 * k + 1] = p1[4 * k + 3]; }
#pragma unroll
              for (int j = 0; j < 16; ++j) W[j] += __int_as_float(__builtin_amdgcn_update_dpp(0, __float_as_int(W[j]), 0x128  , 0xf, 0xf, false));
              const bool b4 = (c.r32 & 16) != 0;
              float mine[8];
#pragma unroll
              for (int j = 0; j < 8; ++j) { const float send = b4 ? W[j] : W[j + 8];
                  const float recv = __int_as_float(__builtin_amdgcn_ds_swizzle(__float_as_int(send), 0x401F  ));
                  mine[j] = (b4 ? W[j + 8] : W[j]) + recv; }
              if ((c.r32 & 8) == 0) { LAS float* ip = impq + c4 + (b4 ? 8 : 0);
                  if (c.hi == 0) { float t[8];
#pragma unroll
                      for (int j = 0; j < 8; ++j) t[j] = ip[j];
#pragma unroll
                      for (int j = 0; j < 8; ++j) ip[j] = t[j] + mine[j]; }
                  asm volatile("" ::: "memory");
                  if (c.hi != 0) { float t[8];
#pragma unroll
                      for (int j = 0; j < 8; ++j) t[j] = ip[j];
#pragma unroll
                      for (int j = 0; j < 8; ++j) ip[j] = t[j] + mine[j]; } } }
            bf16x8 pa0, pa1, pa2, pa3; PK4(p0, 0, pa0); PK4(p0, 8, pa1); PK4(p1, 0, pa2); PK4(p1, 8, pa3);
            if (!(PROBE_DUP == 15 && pflag)) pv_tile(o, vbase, pa0, pa1, pa2, pa3);
        } else {
            float al; bf16x8 pa0, pa1, pa2, pa3;
            partialSM2(p0, p1, m_reg, al);
            if (MODE == 1) { if (__any(al < 1.f)) rescale_rows(o, al, c); }
            finishSM(p0, p1, al, l_reg, pa0, pa1, pa2, pa3); SBAR();
            if (MODE == 1) pv_tile(o, vbase, pa0, pa1, pa2, pa3);
        }
        slot = slot == 2 ? 0 : slot + 1;
    }
    return false;
}

__device__ __forceinline__ void topk_select(const Ctx& c, int cur) {
    const int qi = c.lane >> 3, sub = c.lane & 7, q = c.wid * 8 + qi;
    const LAS float* row = (const LAS float*)(c.lds + L_IMP) + q * IMP_LD;
    LAS unsigned* sm = (LAS unsigned*)(c.lds + L_SELM) + q * 4;
    unsigned mw[4] = {0u, 0u, 0u, 0u};
    const int ncand = cur - 2 > 0 ? cur - 2 : 0;
    const int nforced = cur >= 2 ? 3 : cur + 1;
    const int npick = SELK - nforced;
    if (ncand <= npick) {
#pragma unroll
        for (int w = 0; w < 4; ++w) { const int lo = w * 32; int nb = cur + 1 - lo; nb = nb < 0 ? 0 : (nb > 32 ? 32 : nb); mw[w] = nb == 32 ? 0xffffffffu : ((1u << nb) - 1u); }
    } else {
        float v[16];
#pragma unroll
        for (int j = 0; j < 16; ++j) { const int n = sub * 16 + j; const float x = row[n]; v[j] = (n >= 1 && n <= cur - 2) ? x : -1.0f; }
        for (int it = 0; it < npick; ++it) {
            float bv = v[0]; int bn = sub * 16;
#pragma unroll
            for (int j = 1; j < 16; ++j) { if (v[j] > bv) { bv = v[j]; bn = sub * 16 + j; } }
#pragma unroll
            for (int o = 0; o < 3; ++o) {
                const int ctl = o == 0 ? 0xB1 : (o == 1 ? 0x4E : 0x141);
                const float ov = __int_as_float(o == 0 ? __builtin_amdgcn_update_dpp(0, __float_as_int(bv), 0xB1, 0xf, 0xf, false) : o == 1 ? __builtin_amdgcn_update_dpp(0, __float_as_int(bv), 0x4E, 0xf, 0xf, false) : __builtin_amdgcn_update_dpp(0, __float_as_int(bv), 0x141, 0xf, 0xf, false));
                const int on = o == 0 ? __builtin_amdgcn_update_dpp(0, bn, 0xB1, 0xf, 0xf, false) : o == 1 ? __builtin_amdgcn_update_dpp(0, bn, 0x4E, 0xf, 0xf, false) : __builtin_amdgcn_update_dpp(0, bn, 0x141, 0xf, 0xf, false);
                (void)ctl; const bool take = (ov > bv) | ((ov == bv) & (on < bn)); bv = take ? ov : bv; bn = take ? on : bn; }
#pragma unroll
            for (int j = 0; j < 16; ++j) if (bn == sub * 16 + j) v[j] = -2.0f;
#pragma unroll
            for (int w = 0; w < 4; ++w) if ((bn >> 5) == w) mw[w] |= 1u << (bn & 31);
        }
        mw[0] |= 1u;
#pragma unroll
        for (int w = 0; w < 4; ++w) { if ((cur >> 5) == w) mw[w] |= 1u << (cur & 31); if (cur >= 1 && ((cur - 1) >> 5) == w) mw[w] |= 1u << ((cur - 1) & 31); }
    }
    if (sub == 0) { sm[0] = mw[0]; sm[1] = mw[1]; sm[2] = mw[2]; sm[3] = mw[3]; }
}

__device__ __forceinline__ void nsa_unit(const Args& a, LAS char* lds, int b, int g, int qt, int probe = 0) {
    Ctx c; c.lds = lds; c.tid = TIDX(); c.wid = __builtin_amdgcn_readfirstlane(c.tid >> 6); c.lane = c.tid & 63; c.r32 = c.lane & 31; c.hi = c.lane >> 5;
    c.vb0 = (int)(uintptr_t)(lds + L_V) + v_rd_base(c.lane);
    c.wsf = (LAS float*)(lds + L_WS) + c.wid * 64;
#ifndef NSA_PRIO_SPLIT
#define NSA_PRIO_SPLIT 1
#endif
    if (NSA_PRIO_SPLIT) { if (c.wid & 4) __builtin_amdgcn_s_setprio(0); else __builtin_amdgcn_s_setprio(2); }
    const int hr = c.r32 >> 3, qi = c.r32 & 7, head = g * 4 + hr, q0 = qt * 64, ql = c.wid * 8 + qi, pos = q0 + ql, cur = qt;
    const bf16_t* P = (const bf16_t*)(a.ws + WS_P); const bf16_t* Pb = P + (size_t)b * SEQ * INP;
    const size_t prow = (size_t)(b * SEQ + pos) * INP;
    const float slope = exp2f(-(float)(head + 1)), nslopeS = -slope * 1.4426950408889634f;
    bf16x8 qr[8];
#pragma unroll
    for (int d0 = 0; d0 < 8; ++d0) { const u32x4 qw = *(const u32x4*)(P + prow + PC_QN + head * HD + d0 * 16 + c.hi * 8);
        constexpr float QS = SCALE * 1.4426950408889634f; u32x4 o_;
        o_.x = cvtpk(__uint_as_float(qw.x << 16) * QS, __uint_as_float(qw.x & 0xffff0000u) * QS); o_.y = cvtpk(__uint_as_float(qw.y << 16) * QS, __uint_as_float(qw.y & 0xffff0000u) * QS);
        o_.z = cvtpk(__uint_as_float(qw.z << 16) * QS, __uint_as_float(qw.z & 0xffff0000u) * QS); o_.w = cvtpk(__uint_as_float(qw.w << 16) * QS, __uint_as_float(qw.w & 0xffff0000u) * QS);
        qr[d0] = __builtin_bit_cast(bf16x8, o_); }
    bf16_t graw[3];
#pragma unroll
    for (int j = 0; j < 3; ++j) graw[j] = P[prow + PC_GN + head * 3 + j];
#define GATE(j) sigmoidf_(bf2f(graw[j]))
    LAS int* tl0 = (LAS int*)(lds + L_TL); LAS int* tl1 = tl0 + 132; LAS int* tl2 = tl1 + 132;
    LAS float* imp = (LAS float*)(lds + L_IMP);
    for (int i = c.tid; i < 64 * IMP_LD; i += NT) imp[i] = 0.f;
    const int ncmax = (q0 + 63 >= 31) ? (q0 + 63 - 31) / 16 + 1 : 0, ntc = (ncmax + 63) / 64;
    const int wlo = cur - 8 > 0 ? cur - 8 : 0, ntw = ((PROBE_DUP == 8 || PROBE_DUP >= 12) && probe) ? 0 : cur - wlo + 1;
    if (c.tid < ntc) tl0[c.tid] = (ntc - 1 - c.tid) * 64;
    if (c.tid < ntw) tl2[c.tid] = (cur - c.tid) * 64;
    asm volatile("" :: "v"(qr[0]), "v"(qr[1]), "v"(qr[2]), "v"(qr[3]), "v"(qr[4]), "v"(qr[5]), "v"(qr[6]), "v"(qr[7]));
    __syncthreads();
    f32x16 o[4];
#pragma unroll
    for (int d = 0; d < 4; ++d) o[d] = f32x16{};
    float* scr = (float*)(a.ws + WS_U1);
    const size_t tok0 = (size_t)(b * SEQ + q0 + c.wid * 8);
    u32x4 selw = {0u, 0u, 0u, 0u};
    int ring = 0; bool prew = false;
    const bf16_t* kcp = (const bf16_t*)(a.ws + WS_KC) + (size_t)b * 512 * 2 * HD + g * HD; const bf16_t* vcp = kcp + (size_t)4096 * HD;
    {
        float m = -__builtin_inff(), l = 0.f;
        const Chain none{nullptr, nullptr, 0, nullptr, 0};
        const bool pre2 = attn_pass<0, 0>(c, qr, kcp, vcp, 2 * HD, tl0, (PROBE_DUP == 13 && probe) ? 0 : ntc, pos, nslopeS, selw, m, l, o, nullptr, false, ring, Chain{kcp, vcp, (size_t)(2 * HD), tl0, ntc});
        float invl = l > 0.f ? 1.0f / l : 0.f;
        attn_pass<0, 2>(c, qr, kcp, vcp, 2 * HD, tl0, ((PROBE_DUP == 12 || PROBE_DUP == 13) && probe) ? 0 : ntc, pos, nslopeS, selw, m, invl, o, imp + ql * IMP_LD, pre2, ring, none, probe);
        accum_rows<0>(o, GATE(0), c, scr, nullptr, tok0, g);
    }
    __syncthreads();
    topk_select(c, cur);
    __syncthreads();
    {
        const LAS unsigned* smq = (const LAS unsigned*)(lds + L_SELM) + ql * 4;
        selw.x = smq[0]; selw.y = smq[1]; selw.z = smq[2]; selw.w = smq[3];
        if (c.wid == 0) { const LAS unsigned* s2 = (const LAS unsigned*)(lds + L_SELM) + c.lane * 4;
            unsigned u0 = s2[0], u1 = s2[1], u2 = s2[2], u3 = s2[3];
            u0 = wave_or(u0); u1 = wave_or(u1); u2 = wave_or(u2); u3 = wave_or(u3);
            const int c1 = __builtin_popcount(u1), c2 = __builtin_popcount(u2), c3 = __builtin_popcount(u3);
#pragma unroll
            for (int hb = 0; hb < 2; ++hb) { const int n = c.lane + 64 * hb, w = n >> 5, bit = n & 31;
                const unsigned uw = w == 0 ? u0 : (w == 1 ? u1 : (w == 2 ? u2 : u3));
                if ((uw >> bit) & 1u) { const int above = (bit == 31 ? 0 : __builtin_popcount(uw >> (bit + 1))) + (w < 3 ? c3 : 0) + (w < 2 ? c2 : 0) + (w < 1 ? c1 : 0);
                    tl1[above] = n * 64; } }
            if (c.lane == 0) tl1[128] = __builtin_popcount(u0) + c1 + c2 + c3; }
    }
    __syncthreads();
    const int nts = ((PROBE_DUP == 7 || PROBE_DUP == 8 || PROBE_DUP >= 12) && probe) ? 0 : tl1[128];
    {
        float m = -__builtin_inff(), l = 0.f;
        prew = attn_pass<1, 1>(c, qr, Pb + PC_KS + g * HD, Pb + PC_VS + g * HD, INP, tl1, nts, pos, nslopeS, selw, m, l, o, nullptr, false, ring, Chain{Pb + PC_KW + g * HD, Pb + PC_VW + g * HD, (size_t)INP, tl2, ntw});
        accum_rows<1>(o, l > 0.f ? GATE(1) / l : 0.f, c, scr, nullptr, tok0, g);
#if PROBE_DUP == 7
        { }
#endif
#if PROBE_DUP == 8
        topk_select(c, cur); __syncthreads();
#endif
    }
    {
        float m = -__builtin_inff(), l = 0.f;
        attn_pass<2, 1>(c, qr, Pb + PC_KW + g * HD, Pb + PC_VW + g * HD, INP, tl2, ntw, pos, nslopeS, selw, m, l, o, nullptr, prew, ring, Chain{nullptr, nullptr, 0, nullptr, 0});
        accum_rows<2>(o, l > 0.f ? GATE(2) / l : 0.f, c, scr, (bf16_t*)(a.ws + WS_CAT), tok0, g);
    }
    if (NSA_PRIO_SPLIT) __builtin_amdgcn_s_setprio(0);
    __syncthreads();
}
#undef GATE
#undef PK4
}

__device__ __forceinline__ void phase_nsa(const Args& a, LAS unsigned char* lds, int qidx) {
    int* qh = (int*)(a.ws + WS_CTL + CW_Q + qidx * 256);
    LAS int* ub = (LAS int*)(lds + nsa::L_END);
    const int tid = TIDX();
    const int cpre = gridDim.x == 256 ? CONV_PRE_UNITS : 0;
    const int nct = qidx == 0 ? (CONV_NCT * CONV_B - cpre - CONV_GLA_UNITS) / CONV_B : 0, total = BATCH * NSA_G * 128 + nct;
    if (tid == 0) ub[0] = atomicAdd(qh, 1);
    __syncthreads();
    int t = ub[0];
    __syncthreads();
    while (t < total) {
        int nx = 0; if (tid == 0) nx = atomicAdd(qh, 1);
        if ((t & 1) && (t >> 1) < nct) conv_moe_run(a, lds, cpre + (t >> 1) * CONV_B, 1, CONV_B);
        else { const int u = t - ((t >> 1) < nct ? (t >> 1) : nct); const int qt = 127 - (u >> 3), bg = u & 7;
            nsa::nsa_unit(a, (LAS char*)lds, bg >> 1, bg & 1, qt, qidx); }
        if (tid == 0) ub[0] = nx;
        __syncthreads();
        t = ub[0];
        __syncthreads();
    }
}
namespace gla {
using nsa::v_st; using nsa::v_rd_base; using nsa::crow; using nsa::cvtpk;
constexpr int L_K = 0;
constexpr int L_QH = 16384;
constexpr int QH_LD = 272, KT_LD = 144;
constexpr int L_SEG = L_QH + 18432;
constexpr int L_AF = L_SEG + 2048;
constexpr int L_V = 40960;
constexpr int OT_LD = 260;
constexpr int L_END = L_V + 6 * 16384;

__device__ __forceinline__ void pv2(f32x16* o2, int vbase, bf16x8 pa0, bf16x8 pa1, bf16x8 pa2, bf16x8 pa3) {
#define TRRD(dst, off) asm volatile("ds_read_b64_tr_b16 %0, %1 offset:%2" : "=&v"(dst) : "v"(vbase), "i"(off) : "memory")
#define PV_RD(S, d0) do { constexpr int b_ = (d0) * 512; \
        TRRD(S[0], b_); TRRD(S[4], b_ + 2048); TRRD(S[1], b_ + 4096); TRRD(S[5], b_ + 6144); TRRD(S[2], b_ + 8192); TRRD(S[6], b_ + 10240); TRRD(S[3], b_ + 12288); TRRD(S[7], b_ + 14336); } while (0)
#define PV_MM(S, d0) do { \
        o2[d0] = __builtin_amdgcn_mfma_f32_32x32x16_bf16(pa0, (bf16x8){S[0][0], S[0][1], S[0][2], S[0][3], S[4][0], S[4][1], S[4][2], S[4][3]}, o2[d0], 0, 0, 0);   \
        o2[d0] = __builtin_amdgcn_mfma_f32_32x32x16_bf16(pa1, (bf16x8){S[1][0], S[1][1], S[1][2], S[1][3], S[5][0], S[5][1], S[5][2], S[5][3]}, o2[d0], 0, 0, 0);   \
        o2[d0] = __builtin_amdgcn_mfma_f32_32x32x16_bf16(pa2, (bf16x8){S[2][0], S[2][1], S[2][2], S[2][3], S[6][0], S[6][1], S[6][2], S[6][3]}, o2[d0], 0, 0, 0);   \
        o2[d0] = __builtin_amdgcn_mfma_f32_32x32x16_bf16(pa3, (bf16x8){S[3][0], S[3][1], S[3][2], S[3][3], S[7][0], S[7][1], S[7][2], S[7][3]}, o2[d0], 0, 0, 0); } while (0)
    s16x4 A_[8], B_[8];
    PV_RD(A_, 0); PV_RD(B_, 1);
    asm volatile("s_waitcnt lgkmcnt(8)" : "+v"(A_[0]), "+v"(A_[1]), "+v"(A_[2]), "+v"(A_[3]), "+v"(A_[4]), "+v"(A_[5]), "+v"(A_[6]), "+v"(A_[7]) :: "memory"); __builtin_amdgcn_sched_barrier(0);
    PV_MM(A_, 0); __builtin_amdgcn_sched_barrier(0);
    asm volatile("s_waitcnt lgkmcnt(0)" : "+v"(B_[0]), "+v"(B_[1]), "+v"(B_[2]), "+v"(B_[3]), "+v"(B_[4]), "+v"(B_[5]), "+v"(B_[6]), "+v"(B_[7]) :: "memory"); __builtin_amdgcn_sched_barrier(0);
    PV_MM(B_, 1);
#undef PV_MM
#undef PV_RD
#undef TRRD
}
__device__ __forceinline__ void stage_vimg(LAS char* lds, int img, const bf16_t* src, size_t ld) {
    const int tid = TIDX(), sr = tid >> 4, sc = (tid & 15) * 8;
    const bf16x8 x0 = *(const bf16x8*)(src + (size_t)sr * ld + sc), x1 = *(const bf16x8*)(src + (size_t)(sr + 32) * ld + sc);
    *(LAS bf16x8*)(lds + L_V + img * 16384 + v_st(sr, sc)) = x0; *(LAS bf16x8*)(lds + L_V + img * 16384 + v_st(32 + sr, sc)) = x1;
}
__device__ __forceinline__ void cum_decay(const Args& a, LAS char* lds, int h, float (&bcum)[16], float& tot, const float (&w)[16], const float bgv) {
    const int tid = TIDX(), d = tid & 127, seg = tid >> 7;
    const LAS float* af = (const LAS float*)(lds + L_AF); LAS float* segt = (LAS float*)(lds + L_SEG);
    float run = 0.f;
#pragma unroll
    for (int i = 0; i < 16; ++i) { const int t = seg * 16 + i; float z = bgv;
#pragma unroll
        for (int j = 0; j < 16; j += 4) { const f32x4 av = *(const LAS f32x4*)(af + t * 16 + j); z = fmaf(av[0], w[j], z); z = fmaf(av[1], w[j + 1], z); z = fmaf(av[2], w[j + 2], z); z = fmaf(av[3], w[j + 3], z); }
        const float ls = fminf(z, 0.f) - __logf(1.0f + __expf(-fabsf(z)));
        run += ls * (1.0f / 16.0f); bcum[i] = run; }
    segt[seg * 128 + d] = run;
    __syncthreads();
    const float s0 = segt[d], s1 = segt[128 + d], s2 = segt[256 + d], s3 = segt[384 + d];
    const float off = seg == 0 ? 0.f : (seg == 1 ? s0 : (seg == 2 ? s0 + s1 : (s0 + s1) + s2));
    tot = ((s0 + s1) + s2) + s3;
#pragma unroll
    for (int i = 0; i < 16; ++i) bcum[i] += off;
}
__device__ __forceinline__ void load_atile(const Args& a, LAS char* lds, int row0) {
    const bf16_t* P = (const bf16_t*)(a.ws + WS_P); LAS float* af = (LAS float*)(lds + L_AF);
    for (int e = TIDX(); e < 1024; e += NT) { const int t = e >> 4, j = e & 15; af[e] = bf2f(P[(size_t)(row0 + t) * INP + PC_AG + j]); }
}

constexpr int A_KT = 0, A_SEG = 18432, A_AF = 19456, A_V = 23552, A_HALF = 57344;
__device__ __forceinline__ void phase_a(const Args& a, LAS char* lds0) {
    const int tid = TIDX(), half = __builtin_amdgcn_readfirstlane(tid >> 8), ht = tid & 255, wv = __builtin_amdgcn_readfirstlane((tid >> 6) & 3), lane = tid & 63, r32 = lane & 31, hi = lane >> 5;
    const int d = ht & 127, seg = ht >> 7;
    LAS char* lds = lds0 + half * A_HALF;
    const bf16_t* P = (const bf16_t*)(a.ws + WS_P);
    bf16_t* sloc = (bf16_t*)(a.ws + WS_SLOC); float* dec = (float*)(a.ws + WS_DEC);
    const float* wg = a.in[I_GWG];
    for (int up = blockIdx.x; up < 1024; up += gridDim.x) {
        const int u = up * 2 + half, bh = u >> 7, ci = u & 127, b = bh >> 2, h = bh & 3, row0 = b * SEQ + ci * 64;
        { LAS float* af = (LAS float*)(lds + A_AF); for (int e = ht; e < 1024; e += 256) { const int t = e >> 4, j = e & 15; af[e] = bf2f(P[(size_t)(row0 + t) * INP + PC_AG + j]); } }
        { const int sr = ht >> 4, sc = (ht & 15) * 8;
#pragma unroll
          for (int img = 0; img < 2; ++img)
#pragma unroll
              for (int q = 0; q < 4; ++q) { const int r = sr + 16 * q; const bf16x8 x = *(const bf16x8*)(P + (size_t)(row0 + r) * INP + PC_VG + h * 256 + img * 128 + sc);
                  *(LAS bf16x8*)(lds + A_V + img * 16384 + v_st(r, sc)) = x; } }
        bf16_t kraw[32];
#pragma unroll
        for (int i = 0; i < 32; ++i) kraw[i] = P[(size_t)(row0 + seg * 32 + i) * INP + PC_KG + h * 128 + d];
        float w[16]; const float bgv = a.in[I_GBG][h * 128 + d];
#pragma unroll
        for (int j = 0; j < 16; ++j) w[j] = wg[j * 512 + h * 128 + d];
        __syncthreads();
        float bcum[32], tot;
        { const LAS float* af = (const LAS float*)(lds + A_AF); LAS float* segt = (LAS float*)(lds + A_SEG);
          float run = 0.f;
#pragma unroll
          for (int i = 0; i < 32; ++i) { const int t = seg * 32 + i; float z = bgv;
#pragma unroll
              for (int j = 0; j < 16; j += 4) { const f32x4 av = *(const LAS f32x4*)(af + t * 16 + j); z = fmaf(av[0], w[j], z); z = fmaf(av[1], w[j + 1], z); z = fmaf(av[2], w[j + 2], z); z = fmaf(av[3], w[j + 3], z); }
              const float ls = fminf(z, 0.f) - __logf(1.0f + __expf(-fabsf(z)));
              run += ls * (1.0f / 16.0f); bcum[i] = run; }
          segt[seg * 128 + d] = run;
          __syncthreads();
          const float s0 = segt[d], s1 = segt[128 + d];
          tot = s0 + s1;
          if (seg == 1) {
#pragma unroll
              for (int i = 0; i < 32; ++i) bcum[i] += s0; } }
#pragma unroll
        for (int i = 0; i < 32; i += 2) { const int t = seg * 32 + i;
            *(LAS unsigned*)(lds + A_KT + d * KT_LD + t * 2) = cvt_pk_bf16(bf2f(kraw[i]) * __expf(tot - bcum[i]), bf2f(kraw[i + 1]) * __expf(tot - bcum[i + 1])); }
        if (seg == 0) dec[(size_t)u * 128 + d] = __expf(tot);
        __syncthreads();
        {
            const int db = wv;
            const LAS char* kr = lds + A_KT + (32 * db + r32) * KT_LD + hi * 16;
            const bf16x8 pa0 = *(const LAS bf16x8*)(kr), pa1 = *(const LAS bf16x8*)(kr + 32), pa2 = *(const LAS bf16x8*)(kr + 64), pa3 = *(const LAS bf16x8*)(kr + 96);
            f32x16 o[2][4];
#pragma unroll
            for (int vh = 0; vh < 2; ++vh) {
#pragma unroll
                for (int q = 0; q < 4; ++q) o[vh][q] = f32x16{};
                const int vb = (int)(uintptr_t)(lds + A_V) + vh * 16384 + v_rd_base(lane);
                pv2(o[vh], vb, pa0, pa1, pa2, pa3); pv2(o[vh] + 2, vb + 1024, pa0, pa1, pa2, pa3); }
            __syncthreads();
            LAS char* stg = lds + A_V + wv * 8192;
#pragma unroll
            for (int vh = 0; vh < 2; ++vh) {
#pragma unroll
                for (int r = 0; r < 16; ++r)
#pragma unroll
                    for (int d0 = 0; d0 < 4; ++d0) { const float v = o[vh][d0][r];
                        const float vn = __int_as_float(__builtin_amdgcn_update_dpp(0, __float_as_int(v), 0xB1, 0xf, 0xf, false));
                        if ((r32 & 1) == 0) *(LAS unsigned*)(stg + crow(r, hi) * 256 + (d0 * 32 + r32) * 2) = cvt_pk_bf16(v, vn); }
                asm volatile("s_waitcnt lgkmcnt(0)" ::: "memory");
                bf16_t* sp = sloc + ((size_t)u * 128 + 32 * db) * 256 + 128 * vh;
#pragma unroll
                for (int it = 0; it < 8; ++it) { const int id = it * 64 + lane, row = id >> 4, c16 = id & 15;
                    const u32x4 w = *(const LAS u32x4*)(stg + row * 256 + c16 * 16);
                    *(u32x4*)(sp + (size_t)row * 256 + c16 * 8) = w; }
                asm volatile("s_waitcnt lgkmcnt(0)" ::: "memory"); }
        }
        __syncthreads();
    }
}

__device__ __forceinline__ void phase_b(const Args& a) {
    const bf16_t* sloc = (const bf16_t*)(a.ws + WS_SLOC); const float* dec = (const float*)(a.ws + WS_DEC); bf16_t* st = (bf16_t*)(a.ws + WS_STATE);
    for (int gi = blockIdx.x * NT + TIDX(); gi < 16 * 128 * 64; gi += gridDim.x * NT) {
        const int bh = gi >> 13, d = (gi >> 6) & 127, v4 = (gi & 63) * 4;
        f32x4 S = {0.f, 0.f, 0.f, 0.f};
        const size_t base = ((size_t)bh * 128 * 128 + d) * 256 + v4;
        for (int c0 = 0; c0 < 128; c0 += 8) {
            u32x2 sw[8]; float dc[8];
#pragma unroll
            for (int k = 0; k < 8; ++k) { sw[k] = *(const u32x2*)(sloc + base + (size_t)(c0 + k) * 128 * 256); dc[k] = dec[((size_t)bh * 128 + c0 + k) * 128 + d]; }
#pragma unroll
            for (int k = 0; k < 8; ++k) { const f32x4 sl = {__uint_as_float(sw[k].x << 16), __uint_as_float(sw[k].x & 0xffff0000u), __uint_as_float(sw[k].y << 16), __uint_as_float(sw[k].y & 0xffff0000u)};
                u32x2 w; w.x = cvtpk(S[0], S[1]); w.y = cvtpk(S[2], S[3]); *(u32x2*)(st + base + (size_t)(c0 + k) * 128 * 256) = w;
                S = S * dc[k] + sl; } }
    }
}

__device__ __forceinline__ void phase_c(const Args& a, LAS char* lds) {
    const int tid = TIDX(), wid = __builtin_amdgcn_readfirstlane(tid >> 6), lane = tid & 63, r32 = lane & 31, hi = lane >> 5, d = tid & 127, seg = tid >> 7;
    const bf16_t* P = (const bf16_t*)(a.ws + WS_P); const bf16_t* st = (const bf16_t*)(a.ws + WS_STATE); bf16_t* cat = (bf16_t*)(a.ws + WS_CAT);
    const float* nw = a.in[I_GNW];
    const f32x4 nwv = *(const f32x4*)(nw + lane * 4);
    for (int u = blockIdx.x; u < 2048; u += gridDim.x) {
        const int bh = u >> 7, ci = u & 127, b = bh >> 2, h = bh & 3, row0 = b * SEQ + ci * 64;
        const bf16_t* su = st + (size_t)u * 128 * 256;
        bf16x8 im[6][2];
        { const int sr = tid >> 4, sc = (tid & 15) * 8;
          const bf16_t* vsrc = P + (size_t)row0 * INP + PC_VG + h * 256;
#pragma unroll
          for (int q = 0; q < 2; ++q) { im[0][q] = *(const bf16x8*)(vsrc + (size_t)(sr + 32 * q) * INP + sc); im[1][q] = *(const bf16x8*)(vsrc + (size_t)(sr + 32 * q) * INP + 128 + sc);
              im[2][q] = *(const bf16x8*)(su + (size_t)(sr + 32 * q) * 256 + sc); im[3][q] = *(const bf16x8*)(su + (size_t)(sr + 32 * q) * 256 + 128 + sc);
              im[4][q] = *(const bf16x8*)(su + (size_t)(64 + sr + 32 * q) * 256 + sc); im[5][q] = *(const bf16x8*)(su + (size_t)(64 + sr + 32 * q) * 256 + 128 + sc); } }
        bf16_t araw[2];
#pragma unroll
        for (int q = 0; q < 2; ++q) { const int e = tid + q * NT; araw[q] = P[(size_t)(row0 + (e >> 4)) * INP + PC_AG + (e & 15)]; }
        bf16_t qraw[16], kraw[16];
#pragma unroll
        for (int i = 0; i < 16; ++i) { const size_t ro = (size_t)(row0 + seg * 16 + i) * INP + h * 128 + d; qraw[i] = P[ro + PC_QG]; kraw[i] = P[ro + PC_KG]; }
        float wgc[16]; const float bgv = a.in[I_GBG][h * 128 + d];
#pragma unroll
        for (int j = 0; j < 16; ++j) wgc[j] = a.in[I_GWG][j * 512 + h * 128 + d];
        f32x4 cvw[16]; const ConvU cvd = conv_moe_desc(a, CONV_GLA_BASE + (CONV_GLA_UNITS ? u : 0));
        if (CONV_GLA_UNITS) conv_moe_load(cvw, cvd, true);
        { const int sr = tid >> 4, sc = (tid & 15) * 8;
#pragma unroll
          for (int im_ = 0; im_ < 6; ++im_)
#pragma unroll
              for (int q = 0; q < 2; ++q) *(LAS bf16x8*)(lds + L_V + im_ * 16384 + v_st(sr + 32 * q, sc)) = im[im_][q];
          LAS float* af = (LAS float*)(lds + L_AF);
#pragma unroll
          for (int q = 0; q < 2; ++q) af[tid + q * NT] = bf2f(araw[q]); }
        __syncthreads();
        float bcum[16], tot;
        cum_decay(a, lds, h, bcum, tot, wgc, bgv);
#pragma unroll
        for (int i = 0; i < 16; ++i) { const int t = seg * 16 + i;
            const float qv = bf2f(qraw[i]) * 0.08838834764831845f, kv = bf2f(kraw[i]);
            const float qh = qv * __expf(bcum[i]), kh = kv * __expf(-bcum[i]);
            const float qn = __int_as_float(__builtin_amdgcn_update_dpp(0, __float_as_int(qh), 0xB1, 0xf, 0xf, false)), kn = __int_as_float(__builtin_amdgcn_update_dpp(0, __float_as_int(kh), 0xB1, 0xf, 0xf, false));
            if ((d & 1) == 0) { *(LAS unsigned*)(lds + L_QH + t * QH_LD + d * 2) = cvt_pk_bf16(qh, qn);
                *(LAS unsigned*)(lds + L_K + t * 256 + ((d * 2) ^ ((t & 7) << 4))) = cvt_pk_bf16(kh, kn); } }
        __syncthreads();
        const int rb = wid & 1, cq = wid >> 1, ch = cq >> 1, d0b = (cq & 1) * 2;
        u32x2 rg[8];
#pragma unroll
        for (int i = 0; i < 8; ++i) rg[i] = *(const u32x2*)(P + (size_t)(row0 + wid * 8 + i) * INP + PC_RG + h * 256 + lane * 4);
        f32x16 o2[2]; o2[0] = f32x16{}; o2[1] = f32x16{};
        {
            bf16x8 qr[8];
#pragma unroll
            for (int d0 = 0; d0 < 8; ++d0) qr[d0] = *(const LAS bf16x8*)(lds + L_QH + (32 * rb + r32) * QH_LD + (16 * d0 + 8 * hi) * 2);
            f32x16 p0, p1;
            nsa::qkt(p0, p1, (const LAS char*)(lds + L_K), r32, hi, qr);
            const int t = 32 * rb + r32;
#pragma unroll
            for (int r = 0; r < 16; ++r) { const int s = crow(r, hi); p0[r] = (s <= t) ? p0[r] : 0.f; p1[r] = (s + 32 <= t) ? p1[r] : 0.f; }
            bf16x8 pa0, pa1, pa2, pa3;
#define PK4(P_, B_, OUT) do { unsigned a0 = cvtpk(P_[B_+0], P_[B_+1]), a1 = cvtpk(P_[B_+2], P_[B_+3]); unsigned b0 = cvtpk(P_[B_+4], P_[B_+5]), b1 = cvtpk(P_[B_+6], P_[B_+7]); \
        auto r0 = __builtin_amdgcn_permlane32_swap(a0, b0, false, false); auto r1 = __builtin_amdgcn_permlane32_swap(a1, b1, false, false); \
        u32x4 w_ = {r0[0], r1[0], r0[1], r1[1]}; OUT = *reinterpret_cast<bf16x8*>(&w_); } while (0)
            PK4(p0, 0, pa0); PK4(p0, 8, pa1); PK4(p1, 0, pa2); PK4(p1, 8, pa3);
#undef PK4
            const int vb = (int)(uintptr_t)(lds + L_V) + v_rd_base(lane) + d0b * 512;
            pv2(o2, vb + ch * 16384, pa0, pa1, pa2, pa3);
            pv2(o2, vb + (2 + ch) * 16384, qr[0], qr[1], qr[2], qr[3]);
            pv2(o2, vb + (4 + ch) * 16384, qr[4], qr[5], qr[6], qr[7]);
        }
        __syncthreads();
        { LAS float* ot = (LAS float*)(lds + L_V);
#pragma unroll
          for (int r = 0; r < 16; ++r)
#pragma unroll
              for (int dd = 0; dd < 2; ++dd) ot[(32 * rb + crow(r, hi)) * OT_LD + 128 * ch + 32 * (d0b + dd) + r32] = o2[dd][r]; }
        __syncthreads();
        { const LAS float* ot = (const LAS float*)(lds + L_V);
          f32x4 ovs[8]; float ssq[8];
#pragma unroll
          for (int i = 0; i < 8; ++i) { ovs[i] = *(const LAS f32x4*)(ot + (wid * 8 + i) * OT_LD + lane * 4); ssq[i] = ovs[i][0] * ovs[i][0] + ovs[i][1] * ovs[i][1] + ovs[i][2] * ovs[i][2] + ovs[i][3] * ovs[i][3]; }
#pragma unroll
          for (int i = 0; i < 8; ++i) ssq[i] = wave_sum(ssq[i]);
#pragma unroll
          for (int i = 0; i < 8; ++i) { const int t = wid * 8 + i; const f32x4 ov = ovs[i];
              const float rs = rsqrtf(ssq[i] * (1.0f / 256.0f) + RMS_EPS);
              const u32x2 rr = rg[i];
              const float r0 = __uint_as_float(rr.x << 16), r1 = __uint_as_float(rr.x & 0xffff0000u), r2 = __uint_as_float(rr.y << 16), r3 = __uint_as_float(rr.y & 0xffff0000u);
              u32x2 w; w.x = cvtpk(ov[0] * rs * nwv[0] * (r0 / (1.0f + __expf(-r0))), ov[1] * rs * nwv[1] * (r1 / (1.0f + __expf(-r1))));
              w.y = cvtpk(ov[2] * rs * nwv[2] * (r2 / (1.0f + __expf(-r2))), ov[3] * rs * nwv[3] * (r3 / (1.0f + __expf(-r3))));
              *(u32x2*)(cat + (size_t)(row0 + t) * DM + 1024 + h * 256 + lane * 4) = w; } }
        __syncthreads();
        if (CONV_GLA_UNITS) conv_moe_store(cvw, cvd, (LAS unsigned char*)lds);
    }
}
}
__device__ __forceinline__ void phase_gemm_in(const Args& a, LAS unsigned char* lds, int G, int c) {
    if (IN_BF16_TILES) { pg8::Gemm g{a.ws + WS_H, a.ws + WS_WTIN, DM * 2 / 128, (size_t)DM * 2};
      pg8::StaticOrder S; S.init(NTOK, INP, G, c, IN_FP8_TILES ? IN_BF16_TILES : 0u);
      pg8::EpiBf16Plain E{(bf16_t*)(a.ws + WS_P), INP, nullptr, 0, 1.0f};
      pg8::AMapPlain AM{(size_t)DM * 2};
      pg8::gemm_phase<0>(lds, g, S, E, AM); }
    if (IN_FP8_TILES) { pg8::Gemm g{a.ws + WS_H8, a.ws + WS_WTIN8, DM / 128, (size_t)DM};
      pg8::StaticOrder S; S.init(NTOK, INP, G, c, IN_BF16_TILES ? IN_FP8_TILES : 0u);
      pg8::EpiBf16Plain E{(bf16_t*)(a.ws + WS_P), INP, nullptr, 0, 1.0f / WSCALE};
      pg8::AMapPlain AM{(size_t)DM};
      pg8::gemm_phase<1>(lds, g, S, E, AM); }
}
__device__ __forceinline__ void phase_gemm_out(const Args& a, LAS unsigned char* lds) {
    pg8::Gemm g{a.ws + WS_CAT, a.ws + WS_WTOUT, DM * 2 / 128, (size_t)DM * 2};
    pg8::StaticOrder S; S.init(NTOK, DM, gridDim.x, blockIdx.x);
    pg8::EpiGate E{(bf16_t*)(a.ws + WS_U1) + 2048, 4096, (const float*)(a.ws + WS_MOD) + 2 * DM};
    pg8::AMapPlain AM{(size_t)DM * 2};
    pg8::gemm_phase<0>(lds, g, S, E, AM);
}
__device__ __forceinline__ void phase_moe1(const Args& a, LAS unsigned char* lds) {
    LAS int* tile_e = (LAS int*)(lds + LDS_MISC); LAS int* startp = (LAS int*)(lds + LDS_MISC + 4096); LAS unsigned short* tok = (LAS unsigned short*)(lds + LDS_MISC + 8192);
    const int ntile = moe_meta(a, tile_e, startp);
    pg8::MoeOrder S{tile_e, ntile, 16, (int)gridDim.x, (int)blockIdx.x, (size_t)4096 * DM};
    { const int* st = (const int*)(a.ws + WS_STOK); const int t8 = TIDX();
      int nu = 0; { int pm_, pn_; while (nu < 46 && S.map(nu, pm_, pn_)) ++nu; }
      if (t8 < 256) {
#pragma unroll 1
          for (int i0 = 0; i0 < nu; i0 += 12) {
              int v4[12];
#pragma unroll
              for (int k = 0; k < 12; ++k) { const int i = i0 + k < nu ? i0 + k : nu - 1; int pm_, pn_; S.map(i, pm_, pn_); v4[k] = st[pm_ * 256 + t8]; }
#pragma unroll
              for (int k = 0; k < 12; ++k) if (i0 + k < nu) tok[(i0 + k) * 256 + t8] = (unsigned short)v4[k]; } } }
    asm volatile("" ::: "memory");
    __syncthreads();
    pg8::Gemm g{a.ws + WS_H, a.ws + WS_WTGU, DM / 128, (size_t)DM};
    pg8::EpiSwiglu E{a.ws + WS_ACT, a.in[I_BGU], 1.0f / WSCALE};
    pg8::AMapGather AM{(size_t)DM, tok};
    pg8::gemm_phase<1>(lds, g, S, E, AM);
}
__device__ __forceinline__ void phase_moe2(const Args& a, LAS unsigned char* lds) {
    LAS int* tile_e = (LAS int*)(lds + LDS_MISC); LAS int* startp = (LAS int*)(lds + LDS_MISC + 4096);
    const int ntile = moe_meta(a, tile_e, startp);
    pg8::Gemm g{a.ws + WS_ACT, a.ws + WS_WTDN, DFF / 128, (size_t)DFF};
    pg8::MoeOrder S{tile_e, ntile, 8, (int)gridDim.x, (int)blockIdx.x, (size_t)DM * DFF};
    pg8::EpiBf16Plain E{(bf16_t*)(a.ws + WS_XBUF), DM, a.in[I_BDN], DM, 1.0f / WSCALE};
    pg8::AMapPlain AM{(size_t)DFF};
    pg8::gemm_phase<1>(lds, g, S, E, AM);
}

__device__ __forceinline__ float gelu_tanh_f(float x) { const float u = 0.7978845608028654f * (x + 0.044715f * x * x * x); const float e = __expf(2.0f * u); const float th = 1.0f - 2.0f / (e + 1.0f); return 0.5f * x * (1.0f + th); }
__device__ __forceinline__ void phase_pew1(const Args& a, LAS unsigned char* lds) {
    const int tid = TIDX(), j = tid & 255, kh = tid >> 8;
    LAS float* red = (LAS float*)lds; float* part = (float*)(a.ws + WS_CB);
    for (int u = blockIdx.x; u < 32; u += gridDim.x) { const int kv = u >> 4, kr = u & 15;
        const float* pe = a.in[kv ? I_PEV : I_PEK]; const float* w1 = a.in[kv ? I_W1V : I_W1K];
        float acc = 0.f; const int k0 = kr * 256 + kh * 128;
#pragma unroll 8
        for (int k = 0; k < 128; ++k) acc = fmaf(pe[k0 + k], w1[(size_t)(k0 + k) * CMPH + j], acc);
        if (kh == 1) red[j] = acc;
        __syncthreads();
        if (kh == 0) part[(kv * 16 + kr) * 256 + j] = acc + red[j];
        __syncthreads(); }
}
__device__ __forceinline__ void phase_cmp_gemm(const Args& a, LAS unsigned char* lds) {
    pg8::Gemm g{a.ws + WS_P, a.ws + WS_W1T, 8, (size_t)4096 * 2};
    pg8::CmpOrder S{(int)gridDim.x, (int)blockIdx.x};
    pg8::EpiF32Plain E{(float*)(a.ws + WS_SLAB), CMPH, (size_t)4096 * CMPH};
    pg8::AMapCmp AM;
    pg8::gemm_phase<0>(lds, g, S, E, AM);
}
__device__ __forceinline__ void phase_cmp_fin(const Args& a, LAS unsigned char* lds) {
    const int tid = TIDX(), dcol = tid & 127, jq = tid >> 7;
    LAS float* bias = (LAS float*)lds;
    LAS float* hid = (LAS float*)(lds + 2048);
    LAS float* part = (LAS float*)(lds + 2048 + 4096);
    const float* pp = (const float*)(a.ws + WS_CB); const float* slab = (const float*)(a.ws + WS_SLAB); bf16_t* kc = (bf16_t*)(a.ws + WS_KC);
    { const int kv = tid >> 8, j = tid & 255; float s = a.in[kv ? I_B1V : I_B1K][j];
      for (int r = 0; r < 16; ++r) s += pp[(kv * 16 + r) * 256 + j];
      bias[tid] = s; }
    __syncthreads();
    int kvl = -1; float w2r[64];
    for (int grp = blockIdx.x; grp < 2048; grp += gridDim.x) {
        const int kv = grp >> 10, m0 = (grp & 1023) * 4;
        if (kv != kvl) { const float* w2 = a.in[kv ? I_W2V : I_W2K];
#pragma unroll
            for (int i = 0; i < 64; ++i) w2r[i] = w2[(jq * 64 + i) * HD + dcol];
            kvl = kv; }
        { const int j = tid & 255, r2 = tid >> 8;
#pragma unroll
          for (int rr = 0; rr < 2; ++rr) { const int m = m0 + r2 + 2 * rr; float s = bias[kv * 256 + j];
#pragma unroll
              for (int ks = 0; ks < 8; ++ks) s += slab[((size_t)(kv * 8 + ks) * 4096 + m) * CMPH + j];
              hid[(r2 + 2 * rr) * 256 + j] = gelu_tanh_f(s); } }
        __syncthreads();
#pragma unroll
        for (int r = 0; r < 4; ++r) { float p = 0.f;
#pragma unroll
            for (int i = 0; i < 64; i += 4) { const f32x4 hv = *(const LAS f32x4*)(hid + r * 256 + jq * 64 + i);
                p = fmaf(hv[0], w2r[i], p); p = fmaf(hv[1], w2r[i + 1], p); p = fmaf(hv[2], w2r[i + 2], p); p = fmaf(hv[3], w2r[i + 3], p); }
            part[(r * 4 + jq) * 128 + dcol] = p; }
        __syncthreads();
        { const int r = tid >> 7, m = m0 + r, c = (m >> 1) & 511;
          const float v = ((part[(r * 4 + 0) * 128 + dcol] + part[(r * 4 + 1) * 128 + dcol]) + part[(r * 4 + 2) * 128 + dcol]) + part[(r * 4 + 3) * 128 + dcol];
          kc[((size_t)kv * 4096 + m) * HD + dcol] = c >= NCMP ? (bf16_t)0 : f2bf(v); }
        __syncthreads();
    }
}

#ifndef NGEMM
#define NGEMM 208
#endif
#ifndef PROBE_DUP
#define PROBE_DUP -1
#endif
#define RUN_PHASE(p, call) do { if (a.ph_lo <= (p) && (p) < a.ph_hi) { call; if ((p) + 1 < a.ph_hi) xcd_barrier(bar); } } while (0)
__global__ __launch_bounds__(512, 2) void mk_fwd(Args a) {
    extern __shared__ __attribute__((aligned(16))) unsigned char smem[];
    LAS unsigned char* lds = (LAS unsigned char*)smem;
    volatile LAS unsigned* xbw = (volatile LAS unsigned*)(lds + LDS_BYTES - 16);
    if (threadIdx.x == 0) { xbw[0] = 0u; xbw[1] = 0u; xbw[2] = 0u; xbw[3] = 0u; }
    __syncthreads();
    XcdBarrier bar = xcd_barrier_post((unsigned*)(a.ws + WS_CTL + CW_BAR + (size_t)a.bar_id * 16384), xbw);
    RUN_PHASE(0, (phase_mod(a, lds), phase_pew1(a, lds), phase_conv_small(a, lds), (PROBE_DUP == 30 ? (phase_mod(a, lds), phase_pew1(a, lds), phase_conv_small(a, lds)) : (void)0), phase_conv_moe(a, lds, blockIdx.x, gridDim.x), (PROBE_DUP == 60 ? phase_conv_moe(a, lds, blockIdx.x, gridDim.x) : (void)0)));
    RUN_PHASE(1, (phase_h1(a), (PROBE_DUP == 31 ? phase_h1(a) : (void)0)));
    RUN_PHASE(2, (phase_gemm_in(a, lds, gridDim.x, blockIdx.x), ((gridDim.x == 256 && blockIdx.x >= 128) ? conv_moe_run(a, lds, ((int)blockIdx.x - 128) * CONV_PRE, 1, CONV_PRE) : (void)0)));
    RUN_PHASE(3, (phase_cmp_gemm(a, lds), gla::phase_a(a, (LAS char*)lds), (PROBE_DUP == 33 ? (phase_cmp_gemm(a, lds), gla::phase_a(a, (LAS char*)lds)) : (void)0), (PROBE_DUP == 50 ? phase_cmp_gemm(a, lds) : (void)0), (PROBE_DUP == 51 ? gla::phase_a(a, (LAS char*)lds) : (void)0)));
    RUN_PHASE(4, (phase_cmp_fin(a, lds), gla::phase_b(a), (PROBE_DUP == 34 ? (phase_cmp_fin(a, lds), gla::phase_b(a)) : (void)0), (PROBE_DUP == 52 ? phase_cmp_fin(a, lds) : (void)0), (PROBE_DUP == 53 ? gla::phase_b(a) : (void)0)));
    RUN_PHASE(5, (((PROBE_DUP == 7 || PROBE_DUP == 8 || (PROBE_DUP >= 12 && PROBE_DUP <= 15)) ? phase_nsa(a, lds, 1) : (void)0), phase_nsa(a, lds, 0), (PROBE_DUP == 5 ? phase_nsa(a, lds, 1) : (void)0), gla::phase_c(a, (LAS char*)lds), (PROBE_DUP == 6 ? gla::phase_c(a, (LAS char*)lds) : (void)0)));
    RUN_PHASE(6, (phase_gemm_out(a, lds), (PROBE_DUP == 36 ? phase_gemm_out(a, lds) : (void)0)));
    RUN_PHASE(7, ((PROBE_DUP == 37 ? phase_ln1_router<true>(a, lds) : (void)0), phase_ln1_router<false>(a, lds)));
#if PROBE_DUP == 20
    for (int pb = 0; pb < 10; ++pb) xcd_barrier(bar);
#endif
    RUN_PHASE(8, phase_dispatch(a, lds));
    RUN_PHASE(9, (phase_moe1(a, lds), (PROBE_DUP == 9 ? phase_moe1(a, lds) : (void)0)));
    RUN_PHASE(10, (phase_moe2(a, lds), (PROBE_DUP == 10 ? phase_moe2(a, lds) : (void)0)));
    RUN_PHASE(11, (phase_combine_ln2(a, lds), (PROBE_DUP == 41 ? phase_combine_ln2(a, lds) : (void)0)));
}

extern "C" void kernel_launch(void* const* d_in, const int* in_sizes, int n_in, void* d_out, int out_size, void* d_ws, size_t ws_size, hipStream_t stream) {
    static int grid = 0;
    if (grid == 0) {
        if (n_in != 27 || out_size != NTOK * DM || ws_size < WS_END) { fprintf(stderr, "kernel_launch: unexpected shapes (n_in %d out %d ws %zu need %zu)\n", n_in, out_size, ws_size, (size_t)WS_END); grid = -1; return; }
        int dev = 0, cus = 0, per_cu = 0;
        if (hipGetDevice(&dev) != hipSuccess || hipDeviceGetAttribute(&cus, hipDeviceAttributeMultiprocessorCount, dev) != hipSuccess) { grid = -1; return; }
        if (hipFuncSetAttribute((const void*)mk_fwd, hipFuncAttributeMaxDynamicSharedMemorySize, LDS_BYTES) != hipSuccess) { fprintf(stderr, "kernel_launch: hipFuncSetAttribute failed\n"); grid = -1; return; }
        if (hipOccupancyMaxActiveBlocksPerMultiprocessor(&per_cu, (const void*)mk_fwd, NT, LDS_BYTES) != hipSuccess || per_cu < 1) fprintf(stderr, "kernel_launch: occupancy query says %d\n", per_cu);
        (void)hipGetLastError();
        grid = cus;
    }
    if (grid < 0) return;
    (void)hipMemsetAsync((char*)d_ws + WS_CTL, 0, CTL_BYTES, stream);
    Args a{};
    for (int i = 0; i < 27; ++i) a.in[i] = (const float*)d_in[i];
    a.out = (float*)d_out; a.ws = (unsigned char*)d_ws;
    auto run = [&](int lo, int hi, int bar) { a.ph_lo = lo; a.ph_hi = hi; a.bar_id = bar; hipLaunchKernelGGL(mk_fwd, dim3(grid), dim3(NT), LDS_BYTES, stream, a); };
    run(0, 12, 0);
}
```

```cpp
#ifndef PROBE_DUP
#define PROBE_DUP -1
#endif
#include <hip/hip_runtime.h>
#include <stdint.h>
#include <stdio.h>

#define LAS __attribute__((address_space(3)))
typedef unsigned short bf16_t;
typedef short bf16x8 __attribute__((ext_vector_type(8)));
typedef short s16x4 __attribute__((ext_vector_type(4)));
typedef float f32x4 __attribute__((ext_vector_type(4)));
typedef float f32x2 __attribute__((ext_vector_type(2)));
typedef float f32x16 __attribute__((ext_vector_type(16)));
typedef unsigned u32x4 __attribute__((ext_vector_type(4)));
typedef unsigned u32x2 __attribute__((ext_vector_type(2)));

constexpr int BATCH = 4, SEQ = 8192, DM = 2048, NTOK = BATCH * SEQ;
constexpr int INW = 5672, INP = 5888;
constexpr int HD = 128, NSA_H = 8, NSA_G = 2, NSA_R = 4;
constexpr int NCMP = 511, NCMPP = 512, CMPH = 256;
constexpr int NSEL = 128, SELK = 16, WIN = 512;
constexpr int GLA_H = 4, GLA_DK = 128, GLA_DV = 256, GLA_C = 64, GLA_NC = SEQ / GLA_C;
constexpr int NEXP = 32, TOPK = 4, DFF = 2048, MOEB = 256;
constexpr int NSLOT_MAX = (NTOK * TOPK / MOEB + NEXP) * MOEB;
constexpr float DN_ALPHA = 1.189207115002721f;
constexpr float LN_EPS = 1e-5f, RMS_EPS = 1e-6f;
#ifndef IN_FP8_MASK
#define IN_FP8_MASK 0x7fffffu
#endif
constexpr unsigned IN_FP8_TILES = IN_FP8_MASK;
constexpr unsigned IN_BF16_TILES = 0x7fffffu & ~IN_FP8_TILES;
constexpr float CSCALE = 4.0f;
constexpr float WSCALE = 64.0f;
constexpr int PC_QN = 0, PC_KC = 1024, PC_VC = 1280, PC_KS = 1536, PC_VS = 1792, PC_KW = 2048, PC_VW = 2304;
constexpr int PC_QG = 2560, PC_KG = 3072, PC_VG = 3584, PC_RG = 4608, PC_GN = 5632, PC_AG = 5656;

constexpr size_t al256(size_t x) { return (x + 255) & ~(size_t)255; }
constexpr size_t WS_CTL = 0;
constexpr size_t CTL_BYTES = 65536;
constexpr size_t CW_BAR = 0;
constexpr size_t CW_CNT = 49152;
constexpr size_t CW_CUR = 49152 + 256;
constexpr size_t CW_Q = 49152 + 1024;
constexpr size_t WS_MOD = WS_CTL + CTL_BYTES;
constexpr size_t WS_CB = WS_MOD + al256((size_t)BATCH * 6 * DM * 4);
constexpr size_t WS_WTIN = WS_CB + 65536;
constexpr size_t WS_WTOUT = WS_WTIN + (size_t)INP * DM * 2;
constexpr size_t WS_W1T = WS_WTOUT + (size_t)DM * DM * 2;
constexpr size_t WS_W2T = WS_W1T + (size_t)2 * CMPH * 4096 * 2;
constexpr size_t WS_WTGU = WS_W2T + (size_t)2 * HD * CMPH * 2;
constexpr size_t WS_WTDN = WS_WTGU + (size_t)NEXP * 4096 * DM * 2;
constexpr size_t WS_H = WS_WTDN + (size_t)NEXP * DM * DFF * 2;
constexpr size_t WS_P = WS_H + (size_t)NTOK * DM * 2;
constexpr size_t WS_HID = WS_P + (size_t)NTOK * INP * 2;
constexpr size_t WS_SLAB = WS_HID + (size_t)2 * 4096 * CMPH * 4;
constexpr size_t WS_KC = WS_SLAB + (size_t)16 * 4096 * CMPH * 4;
constexpr size_t WS_CAT = WS_KC + (size_t)2 * 4096 * HD * 2;
constexpr size_t WS_U1 = WS_CAT + (size_t)NTOK * DM * 2;
constexpr size_t WS_TOPI = WS_U1 + (size_t)NTOK * DM * 4;
constexpr size_t WS_TOPW = WS_TOPI + (size_t)NTOK * 4 * 4;
constexpr size_t WS_SLOT = WS_TOPW + (size_t)NTOK * 4 * 4;
constexpr size_t WS_STOK = WS_SLOT + (size_t)NTOK * 4 * 4;
constexpr size_t WS_XBUF = WS_STOK + al256((size_t)NSLOT_MAX * 4);
constexpr size_t WS_ACT = WS_XBUF + (size_t)NSLOT_MAX * DM * 2;
constexpr size_t WS_SLOC = WS_ACT + (size_t)NSLOT_MAX * DM * 2;
constexpr size_t WS_DEC = WS_SLOC + (size_t)2048 * 128 * 256 * 4;
constexpr size_t WS_STATE = WS_DEC + (size_t)2048 * 128 * 4;
constexpr size_t WS_H8 = WS_STATE + (size_t)2048 * 128 * 256 * 2;
constexpr size_t WS_WTIN8 = WS_H8 + (size_t)NTOK * DM;
constexpr size_t WS_END = WS_WTIN8 + (size_t)INP * DM;

struct Args {
    const float* in[27];
    float* out;
    unsigned char* ws;
    int ph_lo, ph_hi, bar_id, pad0;
};
enum { I_X = 0, I_C, I_WADA, I_BADA, I_WIN, I_PEK, I_W1K, I_B1K, I_W2K, I_PEV, I_W1V, I_B1V, I_W2V, I_GWG, I_GBG, I_GNW, I_WOUT, I_LN1G, I_LN1B,
       I_WR, I_BR, I_WGU, I_BGU, I_WDN, I_BDN, I_LN2G, I_LN2B };

__device__ __forceinline__ int TIDX() { int t_ = threadIdx.x; asm volatile("" : "+v"(t_)); return t_; }
__device__ __forceinline__ bf16_t f2bf(float f) { unsigned u = __float_as_uint(f); u += 0x7FFFu + ((u >> 16) & 1u); return (bf16_t)(u >> 16); }
__device__ __forceinline__ float bf2f(bf16_t h) { return __uint_as_float(((unsigned)h) << 16); }
__device__ __forceinline__ unsigned cvt_pk_bf16(float lo, float hi) { unsigned r; asm volatile("v_cvt_pk_bf16_f32 %0, %1, %2" : "=v"(r) : "v"(lo), "v"(hi)); return r; }
__device__ __forceinline__ unsigned pack_fp8x4(float a, float b, float c, float d) {
    int w = __builtin_amdgcn_cvt_pk_fp8_f32(a, b, 0, false); w = __builtin_amdgcn_cvt_pk_fp8_f32(c, d, w, true); return (unsigned)w; }
__device__ __forceinline__ float wave_sum(float v) {
    v += __int_as_float(__builtin_amdgcn_update_dpp(0, __float_as_int(v), 0xB1, 0xf, 0xf, false));
    v += __int_as_float(__builtin_amdgcn_update_dpp(0, __float_as_int(v), 0x4E, 0xf, 0xf, false));
    v += __int_as_float(__builtin_amdgcn_update_dpp(0, __float_as_int(v), 0x141, 0xf, 0xf, false));
    v += __int_as_float(__builtin_amdgcn_update_dpp(0, __float_as_int(v), 0x128, 0xf, 0xf, false));
    v += __int_as_float(__builtin_amdgcn_ds_swizzle(__float_as_int(v), 0x401F));
    { auto rr = __builtin_amdgcn_permlane32_swap(__float_as_uint(v), __float_as_uint(v), false, false); v = __uint_as_float(rr[0]) + __uint_as_float(rr[1]); }
    return v;
}
__device__ __forceinline__ unsigned wave_or(unsigned v) {
    v |= (unsigned)__builtin_amdgcn_update_dpp(0, (int)v, 0xB1, 0xf, 0xf, false);
    v |= (unsigned)__builtin_amdgcn_update_dpp(0, (int)v, 0x4E, 0xf, 0xf, false);
    v |= (unsigned)__builtin_amdgcn_update_dpp(0, (int)v, 0x141, 0xf, 0xf, false);
    v |= (unsigned)__builtin_amdgcn_update_dpp(0, (int)v, 0x128, 0xf, 0xf, false);
    v |= (unsigned)__builtin_amdgcn_ds_swizzle((int)v, 0x401F);
    { auto rr = __builtin_amdgcn_permlane32_swap(v, v, false, false); v = rr[0] | rr[1]; }
    return v;
}
__device__ __forceinline__ float wave_max(float v) {
#pragma unroll
    for (int o = 32; o >= 1; o >>= 1) v = fmaxf(v, __shfl_xor(v, o));
    return v;
}
__device__ __forceinline__ float sigmoidf_(float x) { return 1.0f / (1.0f + __expf(-x)); }
#define XB_TMO      128
#define XB_XCNT(j)  (256  + 64 * (j))
#define XB_XSUB(j)  (1280 + 64 * (j))
#define XB_XGEN(j)  (2304 + 64 * (j))
#define XB_TOP      3328
#define XB_TOPGEN   3392
#define XCD_BAR_WORDS 3456
#define XB_SPIN_CAP (1u << 18)

__device__ __forceinline__ unsigned xb_ld(unsigned* p)              { return __hip_atomic_load(p, __ATOMIC_RELAXED, __HIP_MEMORY_SCOPE_AGENT); }
__device__ __forceinline__ unsigned xb_add(unsigned* p, unsigned v) { return __hip_atomic_fetch_add(p, v, __ATOMIC_RELAXED, __HIP_MEMORY_SCOPE_AGENT); }
__device__ __forceinline__ unsigned xb_xcc_id() { return (unsigned)__builtin_amdgcn_s_getreg((3 << 11) | 20) & 0xFu; }
#define XB_SPIN(cond, bar) do { unsigned _sp = 0; while (cond) { __builtin_amdgcn_s_sleep(1); \
    if ((++_sp & 255u) == 0u) { if (xb_ld(&(bar)[XB_TMO])) break; if (_sp > XB_SPIN_CAP) { atomicAdd(&(bar)[XB_TMO], 1u); break; } } } } while (0)

struct XcdBarrier {
    unsigned* bar; unsigned x;
    volatile LAS unsigned* st;
};

__device__ __forceinline__ XcdBarrier xcd_barrier_post(unsigned* bar, volatile LAS unsigned* st) {
    XcdBarrier b; b.bar = bar; b.x = xb_xcc_id(); b.st = st;
    if (threadIdx.x == 0) (void)xb_add(&bar[XB_XCNT(b.x)], 1u);
    return b;
}
__device__ __forceinline__ void xcd_barrier_complete(unsigned* bar, unsigned x, unsigned& nloc, unsigned& nx) {
    const unsigned G = gridDim.x * gridDim.y * gridDim.z;
    unsigned sum, cnt, mine, sp = 0u;
    for (;;) {
        sum = 0u; cnt = 0u; mine = 0u;
#pragma unroll
        for (unsigned j = 0; j < 16; ++j) { const unsigned c = xb_ld(&bar[XB_XCNT(j)]); sum += c; cnt += (c > 0u) ? 1u : 0u; mine = (j == x) ? c : mine; }
        if (sum == G) break;
        __builtin_amdgcn_s_sleep(1);
        if ((++sp & 255u) == 0u) { if (xb_ld(&bar[XB_TMO])) break; if (sp > XB_SPIN_CAP) { atomicAdd(&bar[XB_TMO], 1u); break; } }
    }
    nloc = mine > 0u ? mine : 1u; nx = cnt > 0u ? cnt : 1u;
}

__device__ __forceinline__ void xcd_barrier(const XcdBarrier& b) {
    asm volatile("s_waitcnt vmcnt(0)" ::: "memory");
    __syncthreads();
    if (threadIdx.x == 0) {
        unsigned* bar = b.bar;
        __builtin_amdgcn_s_waitcnt(0);
        unsigned nloc = b.st[0], nx = b.st[1];
        if (nloc == 0u) { xcd_barrier_complete(bar, b.x, nloc, nx); b.st[0] = nloc; b.st[1] = nx; }
        const unsigned old = xb_add(&bar[XB_XSUB(b.x)], 1u);
        const unsigned gen = old / nloc;
        if (old + 1u == (gen + 1u) * nloc) {
            __builtin_amdgcn_fence(__ATOMIC_RELEASE, "agent");
            asm volatile("s_waitcnt vmcnt(0)" ::: "memory");
            const unsigned og = xb_add(&bar[XB_TOP], 1u);
            const unsigned tg = og / nx;
            if (og + 1u == (tg + 1u) * nx) xb_add(&bar[XB_TOPGEN], 1u);
            else XB_SPIN(xb_ld(&bar[XB_TOPGEN]) == tg, bar);
            __builtin_amdgcn_fence(__ATOMIC_ACQUIRE, "agent");
            xb_add(&bar[XB_XGEN(b.x)], 1u);
            asm volatile("s_waitcnt vmcnt(0)" ::: "memory");
        } else {
            XB_SPIN(xb_ld(&bar[XB_XGEN(b.x)]) == gen, bar);
            __builtin_amdgcn_fence(__ATOMIC_ACQUIRE, "agent");
            asm volatile("s_waitcnt vmcnt(0)" ::: "memory");
        }
    }
    __syncthreads();
}
namespace pg8 {
typedef int i32x4 __attribute__((ext_vector_type(4)));
typedef int i32x8 __attribute__((ext_vector_type(8)));
constexpr int BM = 256, BK = 64, HALF = 128, HTB = HALF * BK * 2, STAGE_BYTES = 8 * HTB, NXCD = 8, WGM = 8;
__host__ __device__ __forceinline__ int lds_byte(int r, int c) { const int st = (r >> 4) * 2 + (c >> 5), rr = r & 15, cc = c & 31, ob = rr * 64 + cc * 2; return st * 1024 + (ob ^ (((ob >> 9) & 1) << 5)); }
__host__ __device__ __forceinline__ void stage_rc(int b, int& R, int& C) { const int st = b / 1024, sb = b % 1024, swz = sb ^ (((sb >> 9) & 1) << 5); R = (st >> 1) * 16 + swz / 64; C = (st & 1) * 32 + (swz % 64) / 2; }
__host__ __device__ __forceinline__ int perm32(int rho) { const int n = rho >> 4, i = rho & 15; return 8 * (i >> 2) + 4 * n + (i & 3); }

struct Unit { int pm, pn, e, li; size_t aoff, boff; };
struct AMapPlain { static constexpr bool GATHER = false; size_t ldab;
    __device__ __forceinline__ unsigned voff(int R, int C) const { return (unsigned)(R * ldab + C * 2); }
    __device__ __forceinline__ size_t hstep() const { return (size_t)HALF * ldab; }
    __device__ __forceinline__ size_t kS0() const { return 128; }
    __device__ __forceinline__ size_t kS1() const { return 256; } };
struct AMapGather { static constexpr bool GATHER = true; size_t ldab; const LAS unsigned short* tok;
    __device__ __forceinline__ unsigned voff(int R, int C) const { return (unsigned)(C * 2); }
    __device__ __forceinline__ size_t hstep() const { return 0; }
    __device__ __forceinline__ size_t kS0() const { return 128; }
    __device__ __forceinline__ size_t kS1() const { return 256; }
    __device__ __forceinline__ unsigned row_off(int li, int r) const { return (unsigned)tok[li * 256 + r] * (unsigned)ldab; } };
struct Gemm { const void* A; const void* Bt; int nt; size_t ldbb; };

struct StaticOrder {
    int nM, nN, nwg, G, c; unsigned mask;
    __device__ void init(int M, int N, int G_, int c_, unsigned mask_ = 0u) { nM = M / BM; nN = mask_ ? __builtin_popcount(mask_) : N / BM; nwg = nM * nN; G = G_; c = c_; mask = mask_; }
    __device__ bool next(int i, Unit& u) const {
        const long L = (long)i * G + c; if (L >= nwg) return false;
        int wgid = (int)L; { const int q = nwg / NXCD, r = nwg % NXCD, xcd = wgid % NXCD, off = wgid / NXCD; wgid = (xcd < r ? xcd * (q + 1) : r * (q + 1) + (xcd - r) * q) + off; }
        const int nig = WGM * nN, gid = wgid / nig, fm = gid * WGM, gsz = (nM - fm) < WGM ? (nM - fm) : WGM;
        u.pm = fm + ((wgid % nig) % gsz); u.pn = (wgid % nig) / gsz; u.e = 0; u.li = i;
        if (mask) { unsigned m = mask; for (int k = 0; k < u.pn; ++k) m &= m - 1; u.pn = __builtin_ctz(m); } u.aoff = 0; u.boff = 0; return true;
    }
};
struct MoeOrder {
    const LAS int* tile_e; int ntile, nN, G, c; size_t strideE;
    __device__ bool map(int i, int& pm, int& pn) const {
        if (G == 256) { const int PX = nN >> 2, x = c & 7, j = c >> 3; pm = (i * (8 / PX) + x / PX) * 8 + (j & 7); pn = (x % PX) * 4 + (j >> 3); return pm < ntile; }
        const long L = (long)i * G + c; pm = (int)(L / nN); pn = (int)(L % nN); return L < (long)ntile * nN;
    }
    __device__ bool next(int i, Unit& u) const {
        int pm, pn; if (!map(i, pm, pn)) return false;
        u.pm = pm; u.pn = pn; u.e = tile_e[pm]; u.li = i; u.aoff = 0; u.boff = (size_t)u.e * strideE; return true;
    }
};

struct MoeChunkOrder {
    const LAS int* tile_e; int base, cnt, nN; size_t strideE;
    __device__ bool next(int i, Unit& u) const {
        if (i >= cnt) return false; const int L = base + i;
        u.pm = L / nN; u.pn = L % nN; u.e = tile_e[u.pm]; u.li = i; u.aoff = 0; u.boff = (size_t)u.e * strideE; return true;
    }
};
struct MoeXcdOrder {
    const LAS int* tile_e; int base, cnt, x; size_t strideE;
    __device__ bool next(int i, Unit& u) const {
        if (i >= cnt) return false; const int L = base + i;
        u.pm = L >> 1; u.pn = 2 * x + (L & 1); u.e = tile_e[u.pm]; u.li = i; u.aoff = 0; u.boff = (size_t)u.e * strideE; return true;
    }
};
struct CmpOrder { int G, c;
    __device__ bool next(int i, Unit& u) const {
        const int L = i * G + c; if (L >= 256) return false;
        const int kv = L >> 7, ks = L & 7; u.pm = (L >> 3) & 15; u.pn = 0; u.e = kv * 8 + ks; u.li = i;
        u.aoff = ((size_t)kv * 256 + (size_t)ks * 4 * INP) * 2; u.boff = ((size_t)kv * CMPH * 4096 + (size_t)ks * 512) * 2; return true; } };
struct AMapCmp { static constexpr bool GATHER = false;
    __device__ __forceinline__ unsigned voff(int R, int C) const { return (unsigned)((R >> 1) * 16 * INP + (R & 1) * 128 + PC_KC + C) * 2u; }
    __device__ __forceinline__ size_t hstep() const { return (size_t)64 * 16 * INP * 2; }
    __device__ __forceinline__ size_t kS0() const { return 128; }
    __device__ __forceinline__ size_t kS1() const { return (size_t)INP * 2; } };
#define PG8_ASM_LOAD16(dst, ptr) asm volatile("global_load_dwordx4 %0, %1, off" : "=v"(dst) : "v"(ptr))
struct EpiBf16Plain {
    static constexpr bool PERM = true;
    bf16_t* O; int ldc; const float* bias; int bias_ld; float scale;
    __device__ __forceinline__ void pre(f32x4 (&pv)[4], const Unit& u, int wc, int fq) const {
        const int col0 = u.pn * BM + wc * 32 + 8 * fq;
#pragma unroll
        for (int q = 0; q < 4; ++q) { if (bias) PG8_ASM_LOAD16(pv[q], bias + (size_t)u.e * bias_ld + col0 + (q >> 1) * HALF + 4 * (q & 1)); else pv[q] = (f32x4){0.f, 0.f, 0.f, 0.f}; }
    }
    __device__ __forceinline__ void operator()(const f32x4 (&acc)[2][2][4][2], const Unit& u, int wr, int wc, int fr, int fq, const f32x4 (&pv)[4]) const {
        const int row0 = u.pm * BM + wr * 64 + fr, col0 = u.pn * BM + wc * 32 + 8 * fq;
        f32x4 bv[2][2];
#pragma unroll
        for (int bj = 0; bj < 2; ++bj)
#pragma unroll
            for (int n = 0; n < 2; ++n) bv[bj][n] = pv[bj * 2 + n];
#pragma unroll
        for (int ai = 0; ai < 2; ++ai)
#pragma unroll
            for (int m = 0; m < 4; ++m) { bf16_t* rowp = O + (size_t)(row0 + ai * HALF + m * 16) * ldc + col0;
#pragma unroll
                for (int bj = 0; bj < 2; ++bj) { const f32x4 v0 = acc[ai][bj][m][0] * scale + bv[bj][0], v1 = acc[ai][bj][m][1] * scale + bv[bj][1];
                    u32x4 w; w.x = cvt_pk_bf16(v0[0], v0[1]); w.y = cvt_pk_bf16(v0[2], v0[3]); w.z = cvt_pk_bf16(v1[0], v1[1]); w.w = cvt_pk_bf16(v1[2], v1[3]);
                    *(u32x4*)(rowp + bj * HALF) = w; } }
    }
};
struct EpiF32Plain {
    static constexpr bool PERM = false;
    float* C0; int ldc; size_t estride;
    __device__ __forceinline__ void pre(f32x4 (&pv)[4], const Unit&, int, int) const { pv[0] = pv[1] = pv[2] = pv[3] = (f32x4){0.f, 0.f, 0.f, 0.f}; }
    __device__ __forceinline__ void operator()(const f32x4 (&acc)[2][2][4][2], const Unit& u, int wr, int wc, int fr, int fq, const f32x4 (&)[4]) const {
        float* C = C0 + (size_t)u.e * estride;
        const int row0 = u.pm * BM + wr * 64 + fr, col0 = u.pn * BM + wc * 32 + 4 * fq;
#pragma unroll
        for (int ai = 0; ai < 2; ++ai)
#pragma unroll
            for (int m = 0; m < 4; ++m) { float* rowp = C + (size_t)(row0 + ai * HALF + m * 16) * ldc + col0;
#pragma unroll
                for (int bj = 0; bj < 2; ++bj)
#pragma unroll
                    for (int n = 0; n < 2; ++n) *(f32x4*)(rowp + bj * HALF + n * 16) = acc[ai][bj][m][n]; }
    }
};
struct EpiResid {
    static constexpr bool PERM = false;
    float* C; const float* X; const float* gate  ; float scale;
    __device__ __forceinline__ void pre(f32x4 (&pv)[4], const Unit&, int, int) const { pv[0] = pv[1] = pv[2] = pv[3] = (f32x4){0.f, 0.f, 0.f, 0.f}; }
    __device__ __forceinline__ void operator()(const f32x4 (&acc)[2][2][4][2], const Unit& u, int wr, int wc, int fr, int fq, const f32x4 (&)[4]) const {
        const int row0 = u.pm * BM + wr * 64 + fr, col0 = u.pn * BM + wc * 32 + 4 * fq;
        const int b = (u.pm * BM) / SEQ;
        f32x4 gv[2][2];
#pragma unroll
        for (int bj = 0; bj < 2; ++bj)
#pragma unroll
            for (int n = 0; n < 2; ++n) gv[bj][n] = *(const f32x4*)(gate + (size_t)b * 6 * DM + col0 + bj * HALF + n * 16) * scale;
        f32x4 xv[2][4];
#define PG8_XLOAD(G_, BUF) do { const size_t ro_ = (size_t)(row0 + ((G_) >> 2) * HALF + ((G_) & 3) * 16) * DM + col0; _Pragma("unroll") for (int q_ = 0; q_ < 4; ++q_) xv[BUF][q_] = *(const f32x4*)(X + ro_ + (q_ >> 1) * HALF + (q_ & 1) * 16); } while (0)
        PG8_XLOAD(0, 0);
#pragma unroll
        for (int gi = 0; gi < 8; ++gi) { const int ai = gi >> 2, m = gi & 3; const size_t ro = (size_t)(row0 + ai * HALF + m * 16) * DM + col0;
            if (gi + 1 < 8) PG8_XLOAD(gi + 1, (gi + 1) & 1);
#pragma unroll
            for (int q = 0; q < 4; ++q) { const int bj = q >> 1, n = q & 1;
                *(f32x4*)(C + ro + bj * HALF + n * 16) = xv[gi & 1][q] * DN_ALPHA + gv[bj][n] * acc[ai][bj][m][n]; } }
#undef PG8_XLOAD
    }
};
struct EpiGate {
    static constexpr bool PERM = true;
    bf16_t* O; int ldc; const float* gate  ;
    __device__ __forceinline__ void pre(f32x4 (&pv)[4], const Unit& u, int wc, int fq) const {
        const int col0 = u.pn * BM + wc * 32 + 8 * fq, b = (u.pm * BM) / SEQ;
#pragma unroll
        for (int q = 0; q < 4; ++q) PG8_ASM_LOAD16(pv[q], gate + (size_t)b * 6 * DM + col0 + (q >> 1) * HALF + 4 * (q & 1));
    }
    __device__ __forceinline__ void operator()(const f32x4 (&acc)[2][2][4][2], const Unit& u, int wr, int wc, int fr, int fq, const f32x4 (&pv)[4]) const {
        const int row0 = u.pm * BM + wr * 64 + fr, col0 = u.pn * BM + wc * 32 + 8 * fq;
#pragma unroll
        for (int ai = 0; ai < 2; ++ai)
#pragma unroll
            for (int m = 0; m < 4; ++m) { bf16_t* rowp = O + (size_t)(row0 + ai * HALF + m * 16) * ldc + col0;
#pragma unroll
                for (int bj = 0; bj < 2; ++bj) { const f32x4 v0 = acc[ai][bj][m][0] * pv[bj * 2], v1 = acc[ai][bj][m][1] * pv[bj * 2 + 1];
                    u32x4 w; w.x = cvt_pk_bf16(v0[0], v0[1]); w.y = cvt_pk_bf16(v0[2], v0[3]); w.z = cvt_pk_bf16(v1[0], v1[1]); w.w = cvt_pk_bf16(v1[2], v1[3]);
                    *(u32x4*)(rowp + bj * HALF) = w; } }
    }
};
struct EpiSwiglu {
    static constexpr bool PERM = true;
    unsigned char* O; const float* bias; float scale;
    __device__ __forceinline__ void pre(f32x4 (&pv)[4], const Unit& u, int wc, int fq) const {
        const float* bg = bias + (size_t)u.e * 4096 + u.pn * HALF + wc * 32 + 8 * fq;
        PG8_ASM_LOAD16(pv[0], bg); PG8_ASM_LOAD16(pv[1], bg + 4); PG8_ASM_LOAD16(pv[2], bg + DFF); PG8_ASM_LOAD16(pv[3], bg + DFF + 4);
    }
    __device__ __forceinline__ void operator()(const f32x4 (&acc)[2][2][4][2], const Unit& u, int wr, int wc, int fr, int fq, const f32x4 (&pv)[4]) const {
        const int row0 = u.pm * BM + wr * 64 + fr, j0 = u.pn * HALF + wc * 32 + 8 * fq;
        f32x4 bgv[2], buv[2];
        bgv[0] = pv[0]; bgv[1] = pv[1]; buv[0] = pv[2]; buv[1] = pv[3];
#pragma unroll
        for (int ai = 0; ai < 2; ++ai)
#pragma unroll
            for (int m = 0; m < 4; ++m) { unsigned char* rowp = O + (size_t)(row0 + ai * HALF + m * 16) * DFF + j0;
                float r[8];
#pragma unroll
                for (int n = 0; n < 2; ++n) {
                    const f32x4 sv = {scale, scale, scale, scale};
                    const f32x4 g = __builtin_elementwise_fma(acc[ai][0][m][n], sv, bgv[n]), up = __builtin_elementwise_fma(acc[ai][1][m][n], sv, buv[n]);
#pragma unroll
                    for (int j = 0; j < 4; j += 2) {
                        const f32x2 gg = {fminf(g[j], 7.0f), fminf(g[j + 1], 7.0f)}, uu = {fminf(fmaxf(up[j], -7.0f), 7.0f), fminf(fmaxf(up[j + 1], -7.0f), 7.0f)};
                        const f32x2 xa = gg * (f32x2){-1.702f * 1.4426950408889634f, -1.702f * 1.4426950408889634f};
                        const f32x2 ev = {__builtin_amdgcn_exp2f(xa[0]), __builtin_amdgcn_exp2f(xa[1])};
                        const f32x2 dv = ev + (f32x2){1.0f, 1.0f};
                        const f32x2 rc = {__builtin_amdgcn_rcpf(dv[0]), __builtin_amdgcn_rcpf(dv[1])};
                        const f32x2 o2 = __builtin_elementwise_fma(uu, gg, gg) * rc;
                        r[4 * n + j] = o2[0]; r[4 * n + j + 1] = o2[1]; } }
                u32x2 w; w.x = pack_fp8x4(r[0], r[1], r[2], r[3]); w.y = pack_fp8x4(r[4], r[5], r[6], r[7]);
                *(u32x2*)rowp = w; }
    }
};

template <int OPK  , class Epi, class Sched, class AMap>
__device__ __forceinline__ void gemm_phase(LAS unsigned char* lds, const Gemm g, const Sched& S, const Epi& E, const AMap& AM) {
    const int tid = TIDX(), wid = __builtin_amdgcn_readfirstlane(tid >> 6), lane = tid & 63, wr = wid >> 2, wc = wid & 3, fr = lane & 15, fq = lane >> 4;
    const int nt = g.nt;
    unsigned voffA[2], voffB[2];
#pragma unroll
    for (int i = 0; i < 2; ++i) { int R, C; stage_rc(tid * 16 + i * 8192, R, C); const int Rb = Epi::PERM ? ((R & ~31) + perm32(R & 31)) : R;
        voffA[i] = AM.voff(R, C); voffB[i] = (unsigned)(Rb * g.ldbb + C * 2); }
    unsigned vA0[2], vA1[2], nA0[2], nA1[2];
#define PG8_UNIT_OFFS(U, D0, D1) do { _Pragma("unroll") for (int _i = 0; _i < 2; ++_i) { if constexpr (AMap::GATHER) { int R_, C_; stage_rc(TIDX() * 16 + _i * 8192, R_, C_); \
            D0[_i] = AM.row_off((U).li, R_) + (unsigned)(C_ * 2); D1[_i] = AM.row_off((U).li, HALF + R_) + (unsigned)(C_ * 2); } else { D0[_i] = voffA[_i]; D1[_i] = voffA[_i]; } } } while (0)
    const size_t kstepB = (size_t)(BK * 2);
    const size_t hstepB = (size_t)HALF * g.ldbb, tstepB = 2 * hstepB;
    const size_t hstepA = AM.hstep(), tstepA = 2 * hstepA, kS0 = AM.kS0(), kS1 = AM.kS1();
    const unsigned ldsw = (unsigned)wid * 1024u;
    const int aoff = lds_byte(wr * 64 + fr, fq * 8), boff = lds_byte(wc * 32 + fr, fq * 8);
#define PG8_SA(b, h) (((b) * 2 + (h)) * HTB)
#define PG8_SB(b, h) ((4 + (b) * 2 + (h)) * HTB)
#define PG8_STAGE(bufoff, gbase, voff) do { _Pragma("unroll") for (int _i = 0; _i < 2; ++_i) \
        __builtin_amdgcn_global_load_lds((const unsigned*)((const char*)(gbase) + (voff)[_i]), (LAS unsigned*)(lds + (bufoff) + ldsw + _i * 8192), 16, 0, 0); } while (0)
#define PG8_LDA(dst, b, h) do { _Pragma("unroll") for (int m = 0; m < 4; ++m) { const i32x4 lo_ = *(const LAS i32x4*)(lds + PG8_SA(b, h) + aoff + m * 2048), hi_ = *(const LAS i32x4*)(lds + PG8_SA(b, h) + aoff + m * 2048 + 1024); \
        dst[m] = __builtin_shufflevector(lo_, hi_, 0, 1, 2, 3, 4, 5, 6, 7); } } while (0)
#define PG8_LDB(dst, b, h) do { _Pragma("unroll") for (int n = 0; n < 2; ++n) { const i32x4 lo_ = *(const LAS i32x4*)(lds + PG8_SB(b, h) + boff + n * 2048), hi_ = *(const LAS i32x4*)(lds + PG8_SB(b, h) + boff + n * 2048 + 1024); \
        dst[n] = __builtin_shufflevector(lo_, hi_, 0, 1, 2, 3, 4, 5, 6, 7); } } while (0)
#define PG8_MMA(ai, bj, At, Bt) do { __builtin_amdgcn_s_setprio(1); _Pragma("unroll") for (int m = 0; m < 4; ++m) _Pragma("unroll") for (int n = 0; n < 2; ++n) { \
        if (OPK == 0) { \
            acc[ai][bj][m][n] = __builtin_amdgcn_mfma_f32_16x16x32_bf16(__builtin_bit_cast(bf16x8, __builtin_shufflevector(Bt[n], Bt[n], 0, 1, 2, 3)), __builtin_bit_cast(bf16x8, __builtin_shufflevector(At[m], At[m], 0, 1, 2, 3)), acc[ai][bj][m][n], 0, 0, 0); \
            acc[ai][bj][m][n] = __builtin_amdgcn_mfma_f32_16x16x32_bf16(__builtin_bit_cast(bf16x8, __builtin_shufflevector(Bt[n], Bt[n], 4, 5, 6, 7)), __builtin_bit_cast(bf16x8, __builtin_shufflevector(At[m], At[m], 4, 5, 6, 7)), acc[ai][bj][m][n], 0, 0, 0); } \
        else asm volatile("v_mfma_scale_f32_16x16x128_f8f6f4 %0, %1, %2, %0, %3, %3 op_sel_hi:[0,0,0]" : "+v"(acc[ai][bj][m][n]) : "v"(Bt[n]), "v"(At[m]), "v"(scl1)); } \
        __builtin_amdgcn_s_setprio(0); } while (0)
#define PG8_MMA_Z0(ai, bj, At, Bt) do { __builtin_amdgcn_s_setprio(1); _Pragma("unroll") for (int m = 0; m < 4; ++m) _Pragma("unroll") for (int n = 0; n < 2; ++n) { \
        if (OPK == 0) { \
            acc[ai][bj][m][n] = __builtin_amdgcn_mfma_f32_16x16x32_bf16(__builtin_bit_cast(bf16x8, __builtin_shufflevector(Bt[n], Bt[n], 0, 1, 2, 3)), __builtin_bit_cast(bf16x8, __builtin_shufflevector(At[m], At[m], 0, 1, 2, 3)), acc[ai][bj][m][n], 0, 0, 0); \
            acc[ai][bj][m][n] = __builtin_amdgcn_mfma_f32_16x16x32_bf16(__builtin_bit_cast(bf16x8, __builtin_shufflevector(Bt[n], Bt[n], 4, 5, 6, 7)), __builtin_bit_cast(bf16x8, __builtin_shufflevector(At[m], At[m], 4, 5, 6, 7)), acc[ai][bj][m][n], 0, 0, 0); } \
        else asm volatile("v_mfma_scale_f32_16x16x128_f8f6f4 %0, %1, %2, 0, %3, %3 op_sel_hi:[0,0,0]" : "=&v"(acc[ai][bj][m][n]) : "v"(Bt[n]), "v"(At[m]), "v"(scl1)); } \
        __builtin_amdgcn_s_setprio(0); } while (0)
#define PG8_WAIT_V(n) asm volatile("s_waitcnt vmcnt(" #n ")" ::: "memory")
#define PG8_WAIT_L(n) asm volatile("s_waitcnt lgkmcnt(" #n ")" ::: "memory")
#define PG8_BAR __builtin_amdgcn_s_barrier()
#define PG8_SCHED __builtin_amdgcn_sched_barrier(0)
    Unit cur, nxt; int ui = 0;
    if (!S.next(0, cur)) return;
    int scl1 = 0x7f7f7f7f; asm volatile("" : "+v"(scl1));
    f32x4 acc[2][2][4][2];
    if (OPK == 0) {
#pragma unroll
    for (int a = 0; a < 2; ++a)
#pragma unroll
        for (int b = 0; b < 2; ++b)
#pragma unroll
            for (int m = 0; m < 4; ++m)
#pragma unroll
                for (int n = 0; n < 2; ++n) acc[a][b][m][n] = (f32x4){0.f, 0.f, 0.f, 0.f}; }
    i32x8 At[4], B0[2], B1[2];
    const char* cA = (const char*)g.A + cur.aoff + (size_t)cur.pm * tstepA; const char* cB = (const char*)g.Bt + cur.boff + (size_t)cur.pn * tstepB;
    PG8_UNIT_OFFS(cur, vA0, vA1);
    f32x4 epv[4]; E.pre(epv, cur, wc, fq);
    PG8_STAGE(PG8_SB(0, 0), cB, voffB); PG8_STAGE(PG8_SA(0, 0), cA, vA0); PG8_STAGE(PG8_SB(0, 1), cB + hstepB, voffB); PG8_STAGE(PG8_SA(0, 1), cA + hstepA, vA1);
    if (wr == 1) PG8_BAR;
    PG8_WAIT_V(4); PG8_BAR;
    PG8_STAGE(PG8_SB(1, 0), cB + kstepB, voffB); PG8_STAGE(PG8_SA(1, 0), cA + kS0, vA0); PG8_STAGE(PG8_SB(1, 1), cB + hstepB + kstepB, voffB);
    PG8_WAIT_V(6); PG8_BAR;
    for (;;) {
        const bool has_next = S.next(ui + 1, nxt);
        const char* nA = has_next ? (const char*)g.A + nxt.aoff + (size_t)nxt.pm * tstepA : cA; const char* nB = has_next ? (const char*)g.Bt + nxt.boff + (size_t)nxt.pn * tstepB : cB;
        if (has_next) PG8_UNIT_OFFS(nxt, nA0, nA1); else { nA0[0] = vA0[0]; nA0[1] = vA0[1]; nA1[0] = vA1[0]; nA1[1] = vA1[1]; }
        if (OPK == 1) { const int t = 0;
            const bool last = (t == nt - 2);
            const char* a1 = cA + (size_t)(t >> 1) * kS1 + kS0;
            const char* a2 = last ? nA : cA + (size_t)((t >> 1) + 1) * kS1; const char* b2 = last ? nB : cB + (size_t)(t + 2) * kstepB;
            const char* a3 = a2 + kS0; const char* b3 = b2 + kstepB;
            unsigned s0[2], s1[2];
            s0[0] = last ? nA0[0] : vA0[0]; s0[1] = last ? nA0[1] : vA0[1]; s1[0] = last ? nA1[0] : vA1[0]; s1[1] = last ? nA1[1] : vA1[1];
            PG8_LDB(B0, 0, 0); PG8_SCHED; PG8_LDA(At, 0, 0); PG8_STAGE(PG8_SA(1, 1), a1 + hstepA, vA1);
            PG8_WAIT_L(8); PG8_BAR; PG8_WAIT_L(0); PG8_MMA_Z0(0, 0, At, B0); PG8_BAR; PG8_SCHED;
            PG8_LDB(B1, 0, 1); PG8_STAGE(PG8_SB(0, 0), b2, voffB);
            PG8_BAR; PG8_WAIT_L(0); PG8_MMA_Z0(0, 1, At, B1); PG8_BAR;
            PG8_LDA(At, 0, 1); PG8_STAGE(PG8_SA(0, 0), a2, s0);
            PG8_BAR; PG8_WAIT_L(0); PG8_MMA_Z0(1, 0, At, B0); PG8_BAR; PG8_SCHED;
            PG8_STAGE(PG8_SB(0, 1), b2 + hstepB, voffB);
            PG8_WAIT_V(6); PG8_BAR; PG8_MMA_Z0(1, 1, At, B1); PG8_BAR;
            PG8_LDB(B0, 1, 0); PG8_SCHED; PG8_LDA(At, 1, 0); PG8_STAGE(PG8_SA(0, 1), a2 + hstepA, s1);
            PG8_WAIT_L(8); PG8_BAR; PG8_WAIT_L(0); PG8_MMA(0, 0, At, B0); PG8_BAR; PG8_SCHED;
            PG8_LDB(B1, 1, 1); PG8_STAGE(PG8_SB(1, 0), b3, voffB);
            PG8_BAR; PG8_WAIT_L(0); PG8_MMA(0, 1, At, B1); PG8_BAR;
            PG8_LDA(At, 1, 1); PG8_STAGE(PG8_SA(1, 0), a3, s0);
            PG8_BAR; PG8_WAIT_L(0); PG8_MMA(1, 0, At, B0); PG8_BAR; PG8_SCHED;
            PG8_STAGE(PG8_SB(1, 1), b3 + hstepB, voffB);
            PG8_WAIT_V(6); PG8_BAR; PG8_MMA(1, 1, At, B1); PG8_BAR;
        }
        for (int t = (OPK == 1 ? 2 : 0); t < nt; t += 2) {
            const bool last = (t == nt - 2);
            const char* a1 = cA + (size_t)(t >> 1) * kS1 + kS0;
            const char* a2 = last ? nA : cA + (size_t)((t >> 1) + 1) * kS1; const char* b2 = last ? nB : cB + (size_t)(t + 2) * kstepB;
            const char* a3 = a2 + kS0; const char* b3 = b2 + kstepB;
            unsigned s0[2], s1[2];
            s0[0] = last ? nA0[0] : vA0[0]; s0[1] = last ? nA0[1] : vA0[1]; s1[0] = last ? nA1[0] : vA1[0]; s1[1] = last ? nA1[1] : vA1[1];
            PG8_LDB(B0, 0, 0); PG8_SCHED; PG8_LDA(At, 0, 0); PG8_STAGE(PG8_SA(1, 1), a1 + hstepA, vA1);
            PG8_WAIT_L(8); PG8_BAR; PG8_WAIT_L(0); PG8_MMA(0, 0, At, B0); PG8_BAR; PG8_SCHED;
            PG8_LDB(B1, 0, 1); PG8_STAGE(PG8_SB(0, 0), b2, voffB);
            PG8_BAR; PG8_WAIT_L(0); PG8_MMA(0, 1, At, B1); PG8_BAR;
            PG8_LDA(At, 0, 1); PG8_STAGE(PG8_SA(0, 0), a2, s0);
            PG8_BAR; PG8_WAIT_L(0); PG8_MMA(1, 0, At, B0); PG8_BAR; PG8_SCHED;
            PG8_STAGE(PG8_SB(0, 1), b2 + hstepB, voffB);
            PG8_WAIT_V(6); PG8_BAR; PG8_MMA(1, 1, At, B1); PG8_BAR;
            PG8_LDB(B0, 1, 0); PG8_SCHED; PG8_LDA(At, 1, 0); PG8_STAGE(PG8_SA(0, 1), a2 + hstepA, s1);
            PG8_WAIT_L(8); PG8_BAR; PG8_WAIT_L(0); PG8_MMA(0, 0, At, B0); PG8_BAR; PG8_SCHED;
            PG8_LDB(B1, 1, 1); PG8_STAGE(PG8_SB(1, 0), b3, voffB);
            PG8_BAR; PG8_WAIT_L(0); PG8_MMA(0, 1, At, B1); PG8_BAR;
            PG8_LDA(At, 1, 1); PG8_STAGE(PG8_SA(1, 0), a3, s0);
            PG8_BAR; PG8_WAIT_L(0); PG8_MMA(1, 0, At, B0); PG8_BAR; PG8_SCHED;
            PG8_STAGE(PG8_SB(1, 1), b3 + hstepB, voffB);
            PG8_WAIT_V(6); PG8_BAR; PG8_MMA(1, 1, At, B1); PG8_BAR;
        }
        if (OPK == 1) asm volatile("s_nop 15\n\ts_nop 15" ::: "memory");
        { int tz = TIDX();
          const int wid2 = __builtin_amdgcn_readfirstlane(tz >> 6), lane2 = tz & 63;
          asm volatile("s_waitcnt vmcnt(6)" : "+v"(epv[0]), "+v"(epv[1]), "+v"(epv[2]), "+v"(epv[3]) :: "memory");
          E(acc, cur, wid2 >> 2, wid2 & 3, lane2 & 15, lane2 >> 4, epv);
          if (has_next) E.pre(epv, nxt, wid2 & 3, lane2 >> 4); }
        if (!has_next) break;
        if (OPK == 0) {
#pragma unroll
        for (int a = 0; a < 2; ++a)
#pragma unroll
            for (int b = 0; b < 2; ++b)
#pragma unroll
                for (int m = 0; m < 4; ++m)
#pragma unroll
                    for (int n = 0; n < 2; ++n) acc[a][b][m][n] = (f32x4){0.f, 0.f, 0.f, 0.f}; }
        cur = nxt; cA = nA; cB = nB; ++ui; vA0[0] = nA0[0]; vA0[1] = nA0[1]; vA1[0] = nA1[0]; vA1[1] = nA1[1];
    }
    PG8_WAIT_V(0);
    if (wr == 0) PG8_BAR;
    PG8_BAR;
#undef PG8_UNIT_OFFS
#undef PG8_SA
#undef PG8_SB
#undef PG8_STAGE
#undef PG8_LDA
#undef PG8_LDB
#undef PG8_MMA
#undef PG8_MMA_Z0
#undef PG8_WAIT_V
#undef PG8_WAIT_L
#undef PG8_BAR
#undef PG8_SCHED
}
}
constexpr int NT = 512;
constexpr unsigned IN_FP8_TILES_DECL = 0u;
constexpr int LDS_STAGE = 131072;
constexpr int LDS_MISC = 131072;
constexpr int LDS_BYTES = 163840;

__device__ __forceinline__ void phase_mod(const Args& a, LAS unsigned char* lds) {
    const int tid = TIDX();
    LAS float* sc = (LAS float*)lds;
    LAS float* red = (LAS float*)(lds + 32768);
    const float* c = a.in[I_C]; const float* w = a.in[I_WADA]; const float* bb = a.in[I_BADA];
    float* mod = (float*)(a.ws + WS_MOD);
    bool staged = false;
    for (int u = blockIdx.x; u < 192; u += gridDim.x) {
        if (!staged) { for (int i = tid; i < BATCH * DM; i += NT) { const float v = c[i]; sc[i] = v / (1.0f + __expf(-v)); } staged = true; }
        __syncthreads();
        const int c4 = (tid & 15) * 4, ks = tid >> 4;
        const int col = u * 64 + c4;
        f32x4 acc[4];
#pragma unroll
        for (int b = 0; b < 4; ++b) acc[b] = (f32x4){0.f, 0.f, 0.f, 0.f};
#pragma unroll 8
        for (int i = 0; i < 64; ++i) { const int k = ks * 64 + i; const f32x4 wv = *(const f32x4*)(w + (size_t)k * (6 * DM) + col);
#pragma unroll
            for (int b = 0; b < 4; ++b) acc[b] += wv * sc[b * DM + k]; }
#pragma unroll
        for (int b = 0; b < 4; ++b)
#pragma unroll
            for (int j = 0; j < 4; ++j) red[(ks * 4 + b) * 64 + c4 + j] = acc[b][j];
        __syncthreads();
        if (tid < 256) { const int b = tid >> 6, cc = tid & 63; float s = bb[u * 64 + cc];
            for (int k2 = 0; k2 < 32; ++k2) s += red[(k2 * 4 + b) * 64 + cc];
            mod[(size_t)b * (6 * DM) + u * 64 + cc] = s; }
        __syncthreads();
    }
}

__device__ __forceinline__ int map_col4(int mode, int n) {
    if (mode == 0) return n;
    if (mode == 2) { const int t256 = n >> 8, within = n & 255, half = within >> 7; return half * DFF + t256 * 128 + (within & 127); }
    if (n < 2560) return n;
    if (n < 4608) return n + 24;
    if (n < 5632) return n + 40;
    if (n < 5656) return 2560 + (n - 5632);
    if (n < 5672) return 4632 + (n - 5656);
    return -1;
}
__device__ __forceinline__ void convT_unit(const float* src, int ld, bf16_t* dst, int K, int k0, int n0, int mode, LAS unsigned char* lds) {
    const int tid = TIDX(), l = tid & 63, r = tid >> 6;
    const int sc = map_col4(mode, n0 + 4 * l);
    f32x4 v[8];
    const int scl = sc >= 0 ? sc : 0; const float keep = sc >= 0 ? 1.0f : 0.0f;
#pragma unroll
    for (int i = 0; i < 8; ++i) v[i] = *(const f32x4*)(src + (size_t)(k0 + 8 * r + i) * ld + scl) * keep;
#pragma unroll
    for (int j = 0; j < 4; ++j) { const int n = 4 * l + j;
        u32x4 w; w.x = cvt_pk_bf16(v[0][j], v[1][j]); w.y = cvt_pk_bf16(v[2][j], v[3][j]); w.z = cvt_pk_bf16(v[4][j], v[5][j]); w.w = cvt_pk_bf16(v[6][j], v[7][j]);
        *(LAS u32x4*)(lds + n * 128 + ((r ^ ((n >> 2) & 7)) << 4)) = w; }
    __syncthreads();
#pragma unroll
    for (int j = 0; j < 4; ++j) { const int n = (tid >> 3) + 64 * j, kc = tid & 7;
        const u32x4 w = *(const LAS u32x4*)(lds + n * 128 + ((kc ^ ((n >> 2) & 7)) << 4));
        *(u32x4*)(dst + (size_t)(n0 + n) * K + k0 + 8 * kc) = w; }
    __syncthreads();
}
__device__ __forceinline__ void convT_unit_fp8(const float* src, int ld, unsigned char* dst, int K, int k0, int n0, int mode, LAS unsigned char* lds) {
    const int tid = TIDX(), l = tid & 63, r = tid >> 6;
    const int sc = map_col4(mode, n0 + 4 * l);
    f32x4 v[16];
    const int scl = sc >= 0 ? sc : 0; const float keep = sc >= 0 ? WSCALE : 0.0f;
#pragma unroll
    for (int i = 0; i < 16; ++i) v[i] = *(const f32x4*)(src + (size_t)(k0 + 16 * r + i) * ld + scl) * keep;
#pragma unroll
    for (int j = 0; j < 4; ++j) { const int n = 4 * l + j;
        u32x4 w; w.x = pack_fp8x4(v[0][j], v[1][j], v[2][j], v[3][j]); w.y = pack_fp8x4(v[4][j], v[5][j], v[6][j], v[7][j]);
        w.z = pack_fp8x4(v[8][j], v[9][j], v[10][j], v[11][j]); w.w = pack_fp8x4(v[12][j], v[13][j], v[14][j], v[15][j]);
        *(LAS u32x4*)(lds + n * 128 + ((r ^ ((n >> 2) & 7)) << 4)) = w; }
    __syncthreads();
#pragma unroll
    for (int j = 0; j < 4; ++j) { const int n = (tid >> 3) + 64 * j, kc = tid & 7;
        const u32x4 w = *(const LAS u32x4*)(lds + n * 128 + ((kc ^ ((n >> 2) & 7)) << 4));
        *(u32x4*)(dst + (size_t)(n0 + n) * K + k0 + 16 * kc) = w; }
    __syncthreads();
}
struct ConvJob { const float* src; int ld; bf16_t* dst; int K, Np, mode; };
__device__ __forceinline__ void run_conv_job(const ConvJob& j, int u0, int ustride, LAS unsigned char* lds) {
    const int nkt = j.K / 64, nnt = j.Np / 256, total = nkt * nnt;
    for (int u = u0; u < total; u += ustride) { const int kt = u % nkt, ntl = u / nkt; convT_unit(j.src, j.ld, j.dst, j.K, kt * 64, ntl * 256, j.mode, lds); }
}
__device__ __forceinline__ void phase_conv_small(const Args& a, LAS unsigned char* lds) {
    ConvJob j; if (IN_BF16_TILES) { j = ConvJob{a.in[I_WIN], INW, (bf16_t*)(a.ws + WS_WTIN), DM, INP, 1}; run_conv_job(j, blockIdx.x, gridDim.x, lds); }
    if (IN_FP8_TILES) for (int u = blockIdx.x; u < 16 * 23; u += gridDim.x) convT_unit_fp8(a.in[I_WIN], INW, a.ws + WS_WTIN8, DM, (u & 15) * 128, (u >> 4) * 256, 1, lds);
    j = ConvJob{a.in[I_WOUT], DM, (bf16_t*)(a.ws + WS_WTOUT), DM, DM, 0}; run_conv_job(j, blockIdx.x, gridDim.x, lds);
    j = ConvJob{a.in[I_W1K], CMPH, (bf16_t*)(a.ws + WS_W1T), 4096, CMPH, 0}; run_conv_job(j, blockIdx.x, gridDim.x, lds);
    j = ConvJob{a.in[I_W1V], CMPH, (bf16_t*)(a.ws + WS_W1T) + (size_t)CMPH * 4096, 4096, CMPH, 0}; run_conv_job(j, blockIdx.x, gridDim.x, lds);
}
#ifndef CONV_NCT
#define CONV_NCT 768
#endif
constexpr int CONV_UNITS = NEXP * 384, CONV_B = 16;
constexpr int CONV_PRE = 5, CONV_PRE_UNITS = 128 * CONV_PRE;
static_assert((CONV_NCT * CONV_B - CONV_PRE_UNITS) % CONV_B == 0, "the tickets behind the pre-converted units are whole");
static_assert(CONV_NCT <= 1024 && CONV_NCT * CONV_B <= CONV_UNITS, "conversion tickets interleave with the 1024 attention units");
struct ConvU { const float* src; unsigned char* dst; int ld, K, k0, n0, mode; };
__device__ __forceinline__ ConvU conv_moe_desc(const Args& a, int u) {
    const int e = u / 384, r = u % 384; ConvU c;
    if (r < 256) { c.src = a.in[I_WGU] + (size_t)e * DM * 4096; c.ld = 4096; c.dst = a.ws + WS_WTGU + (size_t)e * 4096 * DM; c.K = DM; c.k0 = (r & 15) * 128; c.n0 = (r >> 4) * 256; c.mode = 2; }
    else { const int r2 = r - 256; c.src = a.in[I_WDN] + (size_t)e * DFF * DM; c.ld = DM; c.dst = a.ws + WS_WTDN + (size_t)e * DM * DFF; c.K = DFF; c.k0 = (r2 & 15) * 128; c.n0 = (r2 >> 4) * 256; c.mode = 0; }
    return c;
}
__device__ __forceinline__ void conv_moe_load(f32x4 (&v)[16], const ConvU& c, bool valid) {
    const int tid = TIDX(), l = tid & 63, r = tid >> 6;
    const float* p = c.src + (size_t)(c.k0 + 16 * r) * c.ld + map_col4(c.mode, c.n0 + 4 * l);
    const size_t st = valid ? (size_t)c.ld : 0;
#pragma unroll
    for (int i = 0; i < 16; ++i) v[i] = __builtin_nontemporal_load((const f32x4*)(p + (size_t)i * st));
}
__device__ __forceinline__ void conv_moe_store(const f32x4 (&v)[16], const ConvU& c, LAS unsigned char* lds) {
    const int tid = TIDX(), l = tid & 63, r = tid >> 6;
#pragma unroll
    for (int j = 0; j < 4; ++j) { const int n = 4 * l + j;
        u32x4 w; w.x = pack_fp8x4(v[0][j] * WSCALE, v[1][j] * WSCALE, v[2][j] * WSCALE, v[3][j] * WSCALE); w.y = pack_fp8x4(v[4][j] * WSCALE, v[5][j] * WSCALE, v[6][j] * WSCALE, v[7][j] * WSCALE);
        w.z = pack_fp8x4(v[8][j] * WSCALE, v[9][j] * WSCALE, v[10][j] * WSCALE, v[11][j] * WSCALE); w.w = pack_fp8x4(v[12][j] * WSCALE, v[13][j] * WSCALE, v[14][j] * WSCALE, v[15][j] * WSCALE);
        *(LAS u32x4*)(lds + n * 128 + ((r ^ ((n >> 2) & 7)) << 4)) = w; }
    __syncthreads();
#pragma unroll
    for (int j = 0; j < 4; ++j) { const int n = (tid >> 3) + 64 * j, kc = tid & 7;
        const u32x4 w = *(const LAS u32x4*)(lds + n * 128 + ((kc ^ ((n >> 2) & 7)) << 4));
        *(u32x4*)(c.dst + (size_t)(c.n0 + n) * c.K + c.k0 + 16 * kc) = w; }
    __syncthreads();
}
__device__ __forceinline__ void conv_moe_run(const Args& a, LAS unsigned char* lds, int ubeg, int ustride, int n) {
    if (n <= 0) return;
    f32x4 b0[16], b1[16], b2[16];
    ConvU c0 = conv_moe_desc(a, ubeg), c1 = conv_moe_desc(a, ubeg + (n > 1 ? ustride : 0));
    conv_moe_load(b0, c0, true); conv_moe_load(b1, c1, n > 1);
#pragma unroll 1
    for (int k = 0; k < n; k += 3) {
        const ConvU c2 = conv_moe_desc(a, ubeg + (k + 2 < n ? k + 2 : n - 1) * ustride); conv_moe_load(b2, c2, k + 2 < n);
        conv_moe_store(b0, c0, lds);
        c0 = conv_moe_desc(a, ubeg + (k + 3 < n ? k + 3 : n - 1) * ustride); conv_moe_load(b0, c0, k + 3 < n);
        if (k + 1 < n) conv_moe_store(b1, c1, lds);
        c1 = conv_moe_desc(a, ubeg + (k + 4 < n ? k + 4 : n - 1) * ustride); conv_moe_load(b1, c1, k + 4 < n);
        if (k + 2 < n) conv_moe_store(b2, c2, lds);
    }
}
__device__ __forceinline__ void phase_conv_moe(const Args& a, LAS unsigned char* lds, int u0, int ustride) {
    const int first = CONV_NCT * CONV_B + u0; if (first < CONV_UNITS) conv_moe_run(a, lds, first, ustride, (CONV_UNITS - first + ustride - 1) / ustride);
}

__device__ __forceinline__ void phase_h1(const Args& a) {
    const float* x = a.in[I_X]; const float* mod = (const float*)(a.ws + WS_MOD); bf16_t* h = (bf16_t*)(a.ws + WS_H); unsigned char* h8 = a.ws + WS_H8;
    { int* stok = (int*)(a.ws + WS_STOK); for (int i = blockIdx.x * NT + TIDX(); i < NSLOT_MAX; i += gridDim.x * NT) stok[i] = 0; }
    const size_t n8 = (size_t)NTOK * DM / 8, stride = (size_t)gridDim.x * NT;
    const int nper = (n8 % (4 * stride) == 0) ? 4 : 1;
    for (size_t i0 = (size_t)blockIdx.x * NT + TIDX(); i0 < n8; i0 += nper * stride) {
        f32x4 xa[4], xb[4], sa[4], sb[4], ha[4], hb[4];
#pragma unroll
        for (int k = 0; k < 4; ++k) if (k < nper) { const size_t e0 = (i0 + k * stride) * 8; const int row = (int)(e0 / DM), col = (int)(e0 % DM), b = row / SEQ;
            const float* mb = mod + (size_t)b * 6 * DM;
            xa[k] = *(const f32x4*)(x + e0); xb[k] = *(const f32x4*)(x + e0 + 4); sa[k] = *(const f32x4*)(mb + DM + col); sb[k] = *(const f32x4*)(mb + DM + col + 4);
            ha[k] = *(const f32x4*)(mb + col); hb[k] = *(const f32x4*)(mb + col + 4); }
#pragma unroll
        for (int k = 0; k < 4; ++k) if (k < nper) { const size_t e0 = (i0 + k * stride) * 8;
            const f32x4 r0 = xa[k] * (sa[k] + 1.0f) + ha[k], r1 = xb[k] * (sb[k] + 1.0f) + hb[k];
            u32x4 w; w.x = cvt_pk_bf16(r0[0], r0[1]); w.y = cvt_pk_bf16(r0[2], r0[3]); w.z = cvt_pk_bf16(r1[0], r1[1]); w.w = cvt_pk_bf16(r1[2], r1[3]);
            if (IN_BF16_TILES) *(u32x4*)(h + e0) = w;
            if (IN_FP8_TILES) { u32x2 w8; w8.x = pack_fp8x4(r0[0], r0[1], r0[2], r0[3]); w8.y = pack_fp8x4(r1[0], r1[1], r1[2], r1[3]); *(u32x2*)(h8 + e0) = w8; } }
    }
}

template <bool DUMMY>
__device__ __forceinline__ void phase_ln1_router(const Args& a, LAS unsigned char* lds) {
    const int tid = TIDX(), wid = tid >> 6, lane = tid & 63;
    const float* xin = a.in[I_X]; const bf16_t* yg = (const bf16_t*)(a.ws + WS_U1) + 2048;
    unsigned char* h2 = a.ws + (DUMMY ? WS_XBUF : WS_H);
    bf16_t* x1o = (bf16_t*)(a.ws + (DUMMY ? WS_SLOC : WS_U1));
    const float* mod = (const float*)(a.ws + WS_MOD);
    const float* g = a.in[I_LN1G]; const float* bt = a.in[I_LN1B]; const float* wr_ = a.in[I_WR]; const float* br = a.in[I_BR];
    int* topi = (int*)(a.ws + (DUMMY ? WS_ACT : WS_TOPI)); float* topw = (float*)(a.ws + (DUMMY ? WS_ACT + (1u << 20) : WS_TOPW)); int* cnt = (int*)(a.ws + WS_CTL + CW_CNT + (DUMMY ? 4096 : 0));
    LAS float* hs = (LAS float*)lds;
    LAS float* part = (LAS float*)(lds + 65536);
    LAS float* lg = (LAS float*)(lds + 65536 + 32768);
    LAS int* hist = (LAS int*)(lds + 65536 + 32768 + 1024);
    LAS float* prm = (LAS float*)(lds + 65536 + 32768 + 4096);
    int bcur = -1;
    if (tid < 32) { hist[tid] = 0; lg[320 + tid] = br[tid]; }
    const int e = tid & 31, ep = tid & 15, ks = tid >> 4;
    f32x2 w0[32], w1[32];
#pragma unroll
    for (int i = 0; i < 32; ++i) { const float* wp = wr_ + (size_t)(ks * 64 + 2 * i) * NEXP + 2 * ep;
        w0[i] = (f32x2){wp[0], wp[NEXP]}; w1[i] = (f32x2){wp[1], wp[NEXP + 1]}; }
    __syncthreads();
    f32x4 v[8]; u32x2 yv[8];
    if ((int)blockIdx.x < NTOK / 8) {
#pragma unroll
        for (int j = 0; j < 8; ++j) { const unsigned r0 = (unsigned)(blockIdx.x * 8 + wid) * 8192u;
            v[j] = *(const f32x4*)((const char*)xin + (size_t)(r0 + j * 1024 + lane * 16)); yv[j] = *(const u32x2*)((const char*)yg + (size_t)(r0 + j * 512 + lane * 8)); } }
    for (int grp = blockIdx.x; grp < NTOK / 8; grp += gridDim.x) {
        int row = grp * 8 + wid; asm volatile("" : "+v"(row));
        const int b = (grp * 8) / SEQ;
        const float* mb = mod + (size_t)b * 6 * DM;
        if (b != bcur) {
            float t0[DM / NT], t1[DM / NT], t2[DM / NT], t3[DM / NT];
#pragma unroll
            for (int k = 0; k < DM / NT; ++k) { const int i = tid + k * NT; t0[k] = g[i]; t1[k] = bt[i]; t2[k] = mb[4 * DM + i]; t3[k] = mb[3 * DM + i]; }
#pragma unroll
            for (int k = 0; k < DM / NT; ++k) { const int i = tid + k * NT; prm[i] = t0[k]; prm[DM + i] = t1[k]; prm[2 * DM + i] = t2[k] + 1.0f; prm[3 * DM + i] = t3[k]; }
            bcur = b; __syncthreads(); }
        unsigned pb = (unsigned)(uintptr_t)prm + (unsigned)lane * 16u;
        asm volatile("" : "+v"(pb));
        const LAS char* pbase = (const LAS char*)(uintptr_t)pb;
        float s = 0.f;
#pragma unroll
        for (int j = 0; j < 8; ++j) { const u32x2 y = yv[j];
            v[j] = v[j] * DN_ALPHA + (f32x4){__uint_as_float(y.x << 16), __uint_as_float(y.x & 0xffff0000u), __uint_as_float(y.y << 16), __uint_as_float(y.y & 0xffff0000u)}; }
#pragma unroll
        for (int j = 0; j < 8; ++j) s += v[j][0] + v[j][1] + v[j][2] + v[j][3];
        const float mu = wave_sum(s) * (1.0f / DM);
        float q = 0.f;
#pragma unroll
        for (int j = 0; j < 8; ++j) { const f32x4 d = v[j] - mu; q += d[0] * d[0] + d[1] * d[1] + d[2] * d[2] + d[3] * d[3]; }
        const float rstd = rsqrtf(wave_sum(q) * (1.0f / DM) + LN_EPS);
#pragma unroll
        for (int j = 0; j < 8; ++j) { const int col = j * 256 + lane * 4;
            if ((j & 3) == 0) __builtin_amdgcn_sched_barrier(0);
            const f32x4 x1 = (v[j] - mu) * rstd * *(const LAS f32x4*)(pbase + j * 1024) + *(const LAS f32x4*)(pbase + j * 1024 + 8192);
            { u32x2 xw; xw.x = cvt_pk_bf16(x1[0], x1[1]); xw.y = cvt_pk_bf16(x1[2], x1[3]); *(u32x2*)((char*)x1o + (size_t)((unsigned)row * 8192u + j * 512 + lane * 8)) = xw; }
            const f32x4 hh = x1 * *(const LAS f32x4*)(pbase + j * 1024 + 16384) + *(const LAS f32x4*)(pbase + j * 1024 + 24576);
            *(unsigned*)(h2 + (size_t)((unsigned)row * 2048u + j * 256 + lane * 4)) = pack_fp8x4(hh[0], hh[1], hh[2], hh[3]);
            *(LAS f32x4*)(hs + wid * DM + col) = hh; }
        if (grp + (int)gridDim.x < NTOK / 8) {
#pragma unroll
            for (int j = 0; j < 8; ++j) { const unsigned rn = (unsigned)(row + (int)gridDim.x * 8) * 8192u; v[j] = *(const f32x4*)((const char*)xin + (size_t)(rn + j * 1024 + lane * 16)); yv[j] = *(const u32x2*)((const char*)yg + (size_t)(rn + j * 512 + lane * 8)); } }
        __syncthreads();
#pragma unroll 1
        for (int r = 0; r < 8; ++r) {
            unsigned hb_ = (unsigned)(uintptr_t)(hs + r * DM + ks * 64); asm volatile("" : "+v"(hb_));
            const LAS f32x4* hr = (const LAS f32x4*)(uintptr_t)hb_;
            f32x2 a0 = {0.f, 0.f}, a0b = {0.f, 0.f}, a1 = {0.f, 0.f}, a1b = {0.f, 0.f};
            f32x4 hb[2];
#pragma unroll
            for (int i = 0; i < 2; ++i) hb[i] = hr[i];
#pragma unroll
            for (int i = 0; i < 16; ++i) { const f32x4 hv = hb[i & 1];
                const f32x2 hl = {hv[0], hv[1]}, hh2 = {hv[2], hv[3]};
                a0 = __builtin_elementwise_fma(hl, w0[2 * i], a0); a0b = __builtin_elementwise_fma(hh2, w0[2 * i + 1], a0b);
                a1 = __builtin_elementwise_fma(hl, w1[2 * i], a1); a1b = __builtin_elementwise_fma(hh2, w1[2 * i + 1], a1b);
                if (i + 2 < 16) hb[i & 1] = hr[i + 2];
                __builtin_amdgcn_sched_barrier(0); }
            const f32x2 pp = {(a0[0] + a0[1]) + (a0b[0] + a0b[1]), (a1[0] + a1[1]) + (a1b[0] + a1b[1])};
            *(LAS f32x2*)(part + (r * 32 + ks) * 32 + 2 * ep) = pp; }
        __syncthreads();
        if (tid < 256) { const int t3 = TIDX(), r = t3 >> 5, e = t3 & 31; float sacc = lg[320 + e];
#pragma unroll
            for (int k2 = 0; k2 < 32; ++k2) sacc += part[(r * 32 + k2) * 32 + e];
            lg[r * 32 + e] = sacc;
            asm volatile("s_waitcnt lgkmcnt(0)" ::: "memory");
            int rank = 0;
#pragma unroll
            for (int j = 0; j < 32; ++j) { const float x = lg[r * 32 + j]; rank += (x > sacc || (x == sacc && j < e)) ? 1 : 0; }
            LAS float* tv = lg + 288 + r * 4;
            if (rank < 4) tv[rank] = sacc;
            asm volatile("s_waitcnt lgkmcnt(0)" ::: "memory");
            if (rank < 4) { const float m = tv[0]; const float se = ((1.0f + __expf(tv[1] - m)) + __expf(tv[2] - m)) + __expf(tv[3] - m);
                const int tok = row - wid + r; topi[tok * 4 + rank] = e; topw[tok * 4 + rank] = __expf(sacc - m) / se; atomicAdd((int*)&hist[e], 1); } }
    }
    __syncthreads();
    if (tid < 32) { const int hv = hist[tid]; if (hv) atomicAdd(&cnt[tid], hv); }
}

__device__ __forceinline__ int moe_meta(const Args& a, LAS int* tile_e, LAS int* startp) {
    const int* cnt = (const int*)(a.ws + WS_CTL + CW_CNT);
    const int tid = TIDX();
    if (tid < 64) {
        const int e2 = tid & 31;
        const int c = __hip_atomic_load(&cnt[e2], __ATOMIC_RELAXED, __HIP_MEMORY_SCOPE_AGENT);
        const int nt2 = (c + MOEB - 1) / MOEB;
        int incl = nt2;
#pragma unroll
        for (int of = 1; of < 32; of <<= 1) { const int v = __shfl_up(incl, of, 32); if (e2 >= of) incl += v; }
        const int excl = incl - nt2;
        if (tid < 32) { startp[e2] = excl * MOEB; if (e2 == 31) startp[NEXP] = incl * MOEB;
            for (int t = 0; t < nt2; ++t) tile_e[excl + t] = e2; }
    }
    __syncthreads();
    return startp[NEXP] / MOEB;
}

__device__ __forceinline__ void phase_dispatch(const Args& a, LAS unsigned char* lds) {
    const int tid = TIDX(), wid = tid >> 6, lane = tid & 63;
    LAS int* tile_e = (LAS int*)(lds); LAS int* startp = (LAS int*)(lds + 4096);
    LAS int* hist = (LAS int*)(lds + 8192); LAS int* base = (LAS int*)(lds + 8192 + 256); LAS int* lcnt = (LAS int*)(lds + 8192 + 512);
    LAS int* slots = (LAS int*)(lds + 16384);
    moe_meta(a, tile_e, startp);
    const int* topi = (const int*)(a.ws + WS_TOPI); int* slot_of = (int*)(a.ws + WS_SLOT); int* cur = (int*)(a.ws + WS_CTL + CW_CUR);
    int* stok = (int*)(a.ws + WS_STOK);
    for (int chunk = blockIdx.x; chunk < NTOK / 128; chunk += gridDim.x) {
        if (tid < 32) { hist[tid] = 0; lcnt[tid] = 0; }
        __syncthreads();
        const int aidx = chunk * 512 + tid; const int e = topi[aidx];
        atomicAdd((int*)&hist[e], 1);
        __syncthreads();
        if (tid < 32) base[tid] = hist[tid] ? atomicAdd(&cur[tid], hist[tid]) : 0;
        __syncthreads();
        const int pos = base[e] + atomicAdd((int*)&lcnt[e], 1);
        const int slot = startp[e] + pos;
        slot_of[aidx] = slot;
        stok[slot] = aidx >> 2;
        __syncthreads();
    }
}

__device__ __forceinline__ void phase_combine_ln2(const Args& a, LAS unsigned char* lds) {
    const int tid = TIDX(), wid = tid >> 6, lane = tid & 63;
    const bf16_t* x1 = (const bf16_t*)(a.ws + WS_U1); const bf16_t* yb = (const bf16_t*)(a.ws + WS_XBUF);
    const int* slot_of = (const int*)(a.ws + WS_SLOT); const float* topw = (const float*)(a.ws + WS_TOPW);
    const float* mod = (const float*)(a.ws + WS_MOD); const float* g = a.in[I_LN2G]; const float* bt = a.in[I_LN2B];
    LAS float* prm = (LAS float*)lds;
    { float t0[DM / NT], t1[DM / NT];
#pragma unroll
      for (int k = 0; k < DM / NT; ++k) { t0[k] = g[tid + k * NT]; t1[k] = bt[tid + k * NT]; }
#pragma unroll
      for (int k = 0; k < DM / NT; ++k) { prm[tid + k * NT] = t0[k]; prm[DM + tid + k * NT] = t1[k]; } }
    __syncthreads();
    unsigned pb = (unsigned)(uintptr_t)prm + (unsigned)lane * 16u; asm volatile("" : "+v"(pb));
    const LAS char* pbase = (const LAS char*)(uintptr_t)pb;
    for (int row = blockIdx.x * 8 + wid; row < NTOK; row += gridDim.x * 8) {
        const int b = row / SEQ; const float* g2 = mod + (size_t)b * 6 * DM + 5 * DM;
        int sl[4]; float w[4];
#pragma unroll
        for (int k = 0; k < 4; ++k) { sl[k] = slot_of[row * 4 + k]; w[k] = topw[row * 4 + k]; }
        f32x4 v[8]; float s = 0.f;
#pragma unroll
        for (int j = 0; j < 8; ++j) { const int col = j * 256 + lane * 4;
            f32x4 f = (f32x4){0.f, 0.f, 0.f, 0.f};
#pragma unroll
            for (int k = 0; k < 4; ++k) { const u32x2 y = *(const u32x2*)(yb + (size_t)sl[k] * DM + col);
                f[0] += w[k] * __uint_as_float(y.x << 16); f[1] += w[k] * __uint_as_float(y.x & 0xffff0000u);
                f[2] += w[k] * __uint_as_float(y.y << 16); f[3] += w[k] * __uint_as_float(y.y & 0xffff0000u); }
            const u32x2 xw = *(const u32x2*)(x1 + (size_t)row * (2 * DM) + col);
            const f32x4 xf = {__uint_as_float(xw.x << 16), __uint_as_float(xw.x & 0xffff0000u), __uint_as_float(xw.y << 16), __uint_as_float(xw.y & 0xffff0000u)};
            v[j] = xf * DN_ALPHA + *(const f32x4*)(g2 + col) * f;
            s += v[j][0] + v[j][1] + v[j][2] + v[j][3]; }
        const float mu = wave_sum(s) * (1.0f / DM);
        float q = 0.f;
#pragma unroll
        for (int j = 0; j < 8; ++j) { const f32x4 d = v[j] - mu; q += d[0] * d[0] + d[1] * d[1] + d[2] * d[2] + d[3] * d[3]; }
        const float rstd = rsqrtf(wave_sum(q) * (1.0f / DM) + LN_EPS);
#pragma unroll
        for (int j = 0; j < 8; ++j) { const int col = j * 256 + lane * 4;
            *(f32x4*)(a.out + (size_t)row * DM + col) = (v[j] - mu) * rstd * *(const LAS f32x4*)(pbase + j * 1024) + *(const LAS f32x4*)(pbase + j * 1024 + 8192); }
    }
}
namespace nsa {
constexpr float SCALE = 0.08838834764831845f;
#ifndef NSA_THR
#define NSA_THR 8.f
#endif
constexpr float THR = NSA_THR;
constexpr int SHM_K = 64 * 128 * 2, SHM_V = 64 * 128 * 2;
constexpr int NSLOT = 3, SLOTB = SHM_V + SHM_K;
constexpr int L_V = 0, L_K = SHM_V, L_WS = NSLOT * SLOTB;
constexpr int L_IMP = L_WS + 8 * 64 * 4;
constexpr int IMP_LD = 132;
constexpr int L_SELM = L_IMP + 64 * IMP_LD * 4;
constexpr int L_TL = L_SELM + 64 * 16;
constexpr int L_END = L_TL + 3 * 132 * 4;
#define KSWZ(row, colB) ((row) * 256 + ((colB) ^ (((row) & 7) << 4)))
#define SBAR() __builtin_amdgcn_sched_barrier(0)
__device__ __forceinline__ int v_st(int k, int c) { const int kk = (k & ~0xC) | ((k & 4) << 1) | ((k & 8) >> 1); return ((kk >> 3) * 4 + (c >> 5)) * 512 + ((kk & 7) * 32 + (c & 31)) * 2; }
__device__ __forceinline__ int v_rd_base(int lane) { return ((lane & 3) << 3) | (((lane >> 2) & 3) << 6) | (((lane >> 4) & 1) << 5) | (((lane >> 5) & 1) << 8); }
constexpr int v_rd_off(int d0, int ks, int half) { return d0 * 512 + ks * 4096 + half * 2048; }
__device__ __forceinline__ int crow(int r, int hi) { return (r & 3) + 8 * (r >> 2) + 4 * hi; }
__device__ __forceinline__ unsigned cvtpk(float lo, float hi) { unsigned r; asm volatile("v_cvt_pk_bf16_f32 %0, %1, %2" : "=v"(r) : "v"(lo), "v"(hi)); return r; }

__device__ __forceinline__ void partialSM(f32x16& p0, f32x16& p1, float& m_reg, float& mn, float& alpha) {
    float mx[4] = {p0[0], p0[1], p0[2], p0[3]};
#pragma unroll
    for (int r = 4; r < 16; r += 4) { mx[0] = fmaxf(mx[0], p0[r]); mx[1] = fmaxf(mx[1], p0[r + 1]); mx[2] = fmaxf(mx[2], p0[r + 2]); mx[3] = fmaxf(mx[3], p0[r + 3]); }
#pragma unroll
    for (int r = 0; r < 16; r += 4) { mx[0] = fmaxf(mx[0], p1[r]); mx[1] = fmaxf(mx[1], p1[r + 1]); mx[2] = fmaxf(mx[2], p1[r + 2]); mx[3] = fmaxf(mx[3], p1[r + 3]); }
    float pmax = fmaxf(fmaxf(mx[0], mx[1]), fmaxf(mx[2], mx[3]));
    { auto rr = __builtin_amdgcn_permlane32_swap(__float_as_uint(pmax), __float_as_uint(pmax), false, false);
      pmax = fmaxf(__uint_as_float(rr[0]), __uint_as_float(rr[1])); }
    constexpr float C2 = 1.4426950408889634f * SCALE;
    if (__builtin_expect(__all((pmax - m_reg) * SCALE <= THR), 1)) { mn = m_reg; alpha = 1.f; }
    else { mn = fmaxf(m_reg, pmax); alpha = __builtin_amdgcn_exp2f((m_reg - mn) * C2); m_reg = mn; }
    const float mnL = -mn * C2;
    for (int r = 0; r < 16; ++r) p0[r] = fmaf(p0[r], C2, mnL); for (int r = 0; r < 16; ++r) p1[r] = fmaf(p1[r], C2, mnL);
    for (int r = 0; r < 16; ++r) p0[r] = __builtin_amdgcn_exp2f(p0[r]);
}
constexpr float THR2 = THR * 1.4426950408889634f;
__device__ __forceinline__ void partialSM2(f32x16& p0, f32x16& p1, float& m_reg, float& alpha) {
    float mx[4] = {p0[0], p0[1], p0[2], p0[3]};
#pragma unroll
    for (int r = 4; r < 16; r += 4) { mx[0] = fmaxf(mx[0], p0[r]); mx[1] = fmaxf(mx[1], p0[r + 1]); mx[2] = fmaxf(mx[2], p0[r + 2]); mx[3] = fmaxf(mx[3], p0[r + 3]); }
#pragma unroll
    for (int r = 0; r < 16; r += 4) { mx[0] = fmaxf(mx[0], p1[r]); mx[1] = fmaxf(mx[1], p1[r + 1]); mx[2] = fmaxf(mx[2], p1[r + 2]); mx[3] = fmaxf(mx[3], p1[r + 3]); }
    float pmax = fmaxf(fmaxf(mx[0], mx[1]), fmaxf(mx[2], mx[3]));
    { auto rr = __builtin_amdgcn_permlane32_swap(__float_as_uint(pmax), __float_as_uint(pmax), false, false);
      pmax = fmaxf(__uint_as_float(rr[0]), __uint_as_float(rr[1])); }
    const float NINF = -__builtin_inff();
    const bool valid = m_reg != NINF;
    const bool need = valid ? (pmax > THR2) : (pmax != NINF);
    alpha = 1.f;
    if (__builtin_expect(__any(need), 0)) {
        const float d = need ? pmax : 0.f;
        alpha = (valid && need) ? __builtin_amdgcn_exp2f(-d) : 1.f;
        m_reg = need ? (valid ? m_reg + d : d) : m_reg;
        for (int r = 0; r < 16; ++r) { p0[r] -= d; p1[r] -= d; }
    }
    for (int r = 0; r < 16; ++r) p0[r] = __builtin_amdgcn_exp2f(p0[r]);
}
#define PK4(P, B_, OUT) do { unsigned a0 = cvtpk(P[B_+0], P[B_+1]), a1 = cvtpk(P[B_+2], P[B_+3]);                          \
        unsigned b0 = cvtpk(P[B_+4], P[B_+5]), b1 = cvtpk(P[B_+6], P[B_+7]);                                             \
        auto r0 = __builtin_amdgcn_permlane32_swap(a0, b0, false, false); auto r1 = __builtin_amdgcn_permlane32_swap(a1, b1, false, false); \
        u32x4 w = {r0[0], r1[0], r0[1], r1[1]}; OUT = *reinterpret_cast<bf16x8*>(&w); } while (0)
__device__ __forceinline__ void finishSM(f32x16& p0, f32x16& p1, float alpha, float& l_reg, bf16x8& pa0, bf16x8& pa1, bf16x8& pa2, bf16x8& pa3) {
    for (int r = 0; r < 16; ++r) p1[r] = __builtin_amdgcn_exp2f(p1[r]);
    float sx[4] = {p0[0], p0[1], p0[2], p0[3]};
#pragma unroll
    for (int r = 4; r < 16; r += 4) { sx[0] += p0[r]; sx[1] += p0[r + 1]; sx[2] += p0[r + 2]; sx[3] += p0[r + 3]; }
#pragma unroll
    for (int r = 0; r < 16; r += 4) { sx[0] += p1[r]; sx[1] += p1[r + 1]; sx[2] += p1[r + 2]; sx[3] += p1[r + 3]; }
    float ps = (sx[0] + sx[1]) + (sx[2] + sx[3]);
    { auto rr = __builtin_amdgcn_permlane32_swap(__float_as_uint(ps), __float_as_uint(ps), false, false);
      ps = __uint_as_float(rr[0]) + __uint_as_float(rr[1]); }
    l_reg = l_reg * alpha + ps;
    PK4(p0, 0, pa0); PK4(p0, 8, pa1); PK4(p1, 0, pa2); PK4(p1, 8, pa3);
}
__device__ __forceinline__ void qkt(f32x16& p0, f32x16& p1, const LAS char* Kimg, int r32, int hi, const bf16x8* qr) {
    p0 = f32x16{}; p1 = f32x16{};
    const LAS char* kb[4];
#pragma unroll
    for (int dd = 0; dd < 4; ++dd) kb[dd] = Kimg + KSWZ(r32, (dd * 16 + hi * 8) * 2);
#pragma unroll
    for (int d0 = 0; d0 < 8; ++d0) { const LAS char* a = kb[d0 & 3] + (d0 >> 2) * 128;
        bf16x8 b0 = *reinterpret_cast<const LAS bf16x8*>(a);
        bf16x8 b1 = *reinterpret_cast<const LAS bf16x8*>(a + 32 * 256);
        p0 = __builtin_amdgcn_mfma_f32_32x32x16_bf16(b0, qr[d0], p0, 0, 0, 0);
        p1 = __builtin_amdgcn_mfma_f32_32x32x16_bf16(b1, qr[d0], p1, 0, 0, 0); }
}
__device__ __forceinline__ void pv_tile(f32x16* o, int vbase, bf16x8 pa0, bf16x8 pa1, bf16x8 pa2, bf16x8 pa3) {
#define TRRD(dst, off) asm volatile("ds_read_b64_tr_b16 %0, %1 offset:%2" : "=&v"(dst) : "v"(vbase), "i"(off) : "memory")
#define PV_RD(S, d0) do { constexpr int b_ = v_rd_off(d0, 0, 0); \
        TRRD(S[0], b_); TRRD(S[4], b_ + 2048); TRRD(S[1], b_ + 4096); TRRD(S[5], b_ + 6144); TRRD(S[2], b_ + 8192); TRRD(S[6], b_ + 10240); TRRD(S[3], b_ + 12288); TRRD(S[7], b_ + 14336); } while (0)
#define PV_MM(S, d0) do { \
        o[d0] = __builtin_amdgcn_mfma_f32_32x32x16_bf16(pa0, (bf16x8){S[0][0], S[0][1], S[0][2], S[0][3], S[4][0], S[4][1], S[4][2], S[4][3]}, o[d0], 0, 0, 0);   \
        o[d0] = __builtin_amdgcn_mfma_f32_32x32x16_bf16(pa1, (bf16x8){S[1][0], S[1][1], S[1][2], S[1][3], S[5][0], S[5][1], S[5][2], S[5][3]}, o[d0], 0, 0, 0);   \
        o[d0] = __builtin_amdgcn_mfma_f32_32x32x16_bf16(pa2, (bf16x8){S[2][0], S[2][1], S[2][2], S[2][3], S[6][0], S[6][1], S[6][2], S[6][3]}, o[d0], 0, 0, 0);   \
        o[d0] = __builtin_amdgcn_mfma_f32_32x32x16_bf16(pa3, (bf16x8){S[3][0], S[3][1], S[3][2], S[3][3], S[7][0], S[7][1], S[7][2], S[7][3]}, o[d0], 0, 0, 0); } while (0)
    s16x4 A_[8], B_[8];
    PV_RD(A_, 0);
    PV_RD(B_, 1); asm volatile("s_waitcnt lgkmcnt(8)" : "+v"(A_[0]), "+v"(A_[1]), "+v"(A_[2]), "+v"(A_[3]), "+v"(A_[4]), "+v"(A_[5]), "+v"(A_[6]), "+v"(A_[7]) :: "memory"); SBAR(); PV_MM(A_, 0); SBAR();
    PV_RD(A_, 2); asm volatile("s_waitcnt lgkmcnt(8)" : "+v"(B_[0]), "+v"(B_[1]), "+v"(B_[2]), "+v"(B_[3]), "+v"(B_[4]), "+v"(B_[5]), "+v"(B_[6]), "+v"(B_[7]) :: "memory"); SBAR(); PV_MM(B_, 1); SBAR();
    PV_RD(B_, 3); asm volatile("s_waitcnt lgkmcnt(8)" : "+v"(A_[0]), "+v"(A_[1]), "+v"(A_[2]), "+v"(A_[3]), "+v"(A_[4]), "+v"(A_[5]), "+v"(A_[6]), "+v"(A_[7]) :: "memory"); SBAR(); PV_MM(A_, 2); SBAR();
    asm volatile("s_waitcnt lgkmcnt(0)" : "+v"(B_[0]), "+v"(B_[1]), "+v"(B_[2]), "+v"(B_[3]), "+v"(B_[4]), "+v"(B_[5]), "+v"(B_[6]), "+v"(B_[7]) :: "memory"); SBAR(); PV_MM(B_, 3);
#undef PV_MM
#undef PV_RD
#undef TRRD
}

template <int BR>
__device__ __forceinline__ void bias_mask(f32x16& p0, f32x16& p1, int pos, int krow0, int hi, float nslopeS, bool selected, bool need_mask) {
    const float NEG = -__builtin_inff();
    if (BR == 0) {
        const int dq = pos - 16 * (krow0 + 4 * hi);
        const float base = ((float)dq - 15.5f) * nslopeS;
        if (need_mask) {
#pragma unroll
            for (int r = 0; r < 16; ++r) { const int c = (r & 3) + 8 * (r >> 2);
                const float b0 = fmaf((float)(-16 * c), nslopeS, base), b1 = fmaf((float)(-16 * c - 512), nslopeS, base);
                p0[r] = (dq - 16 * c >= 31) ? p0[r] + b0 : NEG;
                p1[r] = (dq - 16 * c - 512 >= 31) ? p1[r] + b1 : NEG; }
        } else {
#pragma unroll
            for (int r = 0; r < 16; ++r) { const int c = (r & 3) + 8 * (r >> 2);
                p0[r] += fmaf((float)(-16 * c), nslopeS, base); p1[r] += fmaf((float)(-16 * c - 512), nslopeS, base); }
        }
    } else {
        const int dq = pos - krow0 - 4 * hi;
        float base = (float)dq * nslopeS;
        if (BR == 1 && !selected) base = NEG;
        if (need_mask) {
#pragma unroll
            for (int r = 0; r < 16; ++r) { const int c = (r & 3) + 8 * (r >> 2);
                const float b0 = fmaf((float)(-c), nslopeS, base), b1 = fmaf((float)(-c - 32), nslopeS, base);
                bool v0, v1;
                if (BR == 1) { v0 = (dq - c >= 0); v1 = (dq - c - 32 >= 0); }
                else { v0 = (unsigned)(dq - c) < (unsigned)WIN; v1 = (unsigned)(dq - c - 32) < (unsigned)WIN; }
                p0[r] = v0 ? p0[r] + b0 : NEG; p1[r] = v1 ? p1[r] + b1 : NEG; }
        } else {
#pragma unroll
            for (int r = 0; r < 16; ++r) { const int c = (r & 3) + 8 * (r >> 2);
                p0[r] += fmaf((float)(-c), nslopeS, base); p1[r] += fmaf((float)(-c - 32), nslopeS, base); }
        }
    }
}

__device__ __forceinline__ void qkt_acc(f32x16& p0, f32x16& p1, const LAS char* Kimg, int r32, int hi, const bf16x8* qr) {
    const LAS char* kb[4];
#pragma unroll
    for (int dd = 0; dd < 4; ++dd) kb[dd] = Kimg + KSWZ(r32, (dd * 16 + hi * 8) * 2);
    bf16x8 f0[3], f1[3];
#pragma unroll
    for (int d0 = 0; d0 < 2; ++d0) { const LAS char* a = kb[d0 & 3] + (d0 >> 2) * 128; f0[d0] = *reinterpret_cast<const LAS bf16x8*>(a); f1[d0] = *reinterpret_cast<const LAS bf16x8*>(a + 32 * 256); }
#pragma unroll
    for (int d0 = 0; d0 < 8; ++d0) {
        if (d0 + 2 < 8) { const LAS char* a = kb[(d0 + 2) & 3] + ((d0 + 2) >> 2) * 128; f0[(d0 + 2) % 3] = *reinterpret_cast<const LAS bf16x8*>(a); f1[(d0 + 2) % 3] = *reinterpret_cast<const LAS bf16x8*>(a + 32 * 256); }
        SBAR();
        p0 = __builtin_amdgcn_mfma_f32_32x32x16_bf16(f0[d0 % 3], qr[d0], p0, 0, 0, 0);
        p1 = __builtin_amdgcn_mfma_f32_32x32x16_bf16(f1[d0 % 3], qr[d0], p1, 0, 0, 0);
        SBAR(); }
}
template <int BR>
__device__ __forceinline__ void bias_init(f32x16& p0, f32x16& p1, int pos, int krow0, int hi, float nslopeS, bool selected, float shift) {
    if (BR == 0) {
        const int dq = pos - 16 * (krow0 + 4 * hi);
        const float base = fmaf((float)dq - 15.5f, nslopeS, -shift);
#pragma unroll
        for (int r = 0; r < 16; ++r) { const int c = (r & 3) + 8 * (r >> 2);
            p0[r] = fmaf((float)(-16 * c), nslopeS, base); p1[r] = fmaf((float)(-16 * c - 512), nslopeS, base); }
    } else {
        const int dq = pos - krow0 - 4 * hi;
        float base = fmaf((float)dq, nslopeS, -shift);
        if (BR == 1 && !selected) base = -__builtin_inff();
#pragma unroll
        for (int r = 0; r < 16; ++r) { const int c = (r & 3) + 8 * (r >> 2);
            p0[r] = fmaf((float)(-c), nslopeS, base); p1[r] = fmaf((float)(-c - 32), nslopeS, base); }
    }
}
template <int BR>
__device__ __forceinline__ void mask_only(f32x16& p0, f32x16& p1, int pos, int krow0, int hi) {
    const float NEG = -__builtin_inff();
    if (BR == 0) {
        const int dq = pos - 16 * (krow0 + 4 * hi);
#pragma unroll
        for (int r = 0; r < 16; ++r) { const int c = (r & 3) + 8 * (r >> 2);
            p0[r] = (dq - 16 * c >= 31) ? p0[r] : NEG; p1[r] = (dq - 16 * c - 512 >= 31) ? p1[r] : NEG; }
    } else {
        const int dq = pos - krow0 - 4 * hi;
#pragma unroll
        for (int r = 0; r < 16; ++r) { const int c = (r & 3) + 8 * (r >> 2);
            bool v0, v1;
            if (BR == 1) { v0 = (dq - c >= 0); v1 = (dq - c - 32 >= 0); }
            else { v0 = (unsigned)(dq - c) < (unsigned)WIN; v1 = (unsigned)(dq - c - 32) < (unsigned)WIN; }
            p0[r] = v0 ? p0[r] : NEG; p1[r] = v1 ? p1[r] : NEG; }
    }
}

__device__ __forceinline__ void lds_add(LAS float* p, float v) { asm volatile("ds_add_f32 %0, %1" :: "v"((unsigned)(uintptr_t)p), "v"(v) : "memory"); }
struct Ctx {
    LAS char* lds; int tid, wid, lane, r32, hi;
    int vb0;
    LAS float* wsf;
};
__device__ __forceinline__ void glds_tile(const Ctx& c, const bf16_t* Kp, const bf16_t* Vp, size_t ld, int krow0, int slot) {
#pragma unroll
    for (int i = 0; i < 2; ++i) { const int p = c.tid * 16 + i * 8192;
        const int row = p >> 8, ch = ((p >> 4) & 15) ^ (row & 7);
        const int st = p >> 9, kk = (st >> 2) * 8 + ((p >> 6) & 7), k = (kk & ~0xC) | ((kk & 4) << 1) | ((kk & 8) >> 1), col = (st & 3) * 32 + ((p >> 4) & 3) * 8;
        __builtin_amdgcn_global_load_lds((const unsigned*)(Vp + (size_t)(krow0 + k) * ld + col), (LAS unsigned*)(c.lds + slot * SLOTB + L_V + c.wid * 1024 + i * 8192), 16, 0, 0);
        __builtin_amdgcn_global_load_lds((const unsigned*)(Kp + (size_t)(krow0 + row) * ld + ch * 8), (LAS unsigned*)(c.lds + slot * SLOTB + L_K + c.wid * 1024 + i * 8192), 16, 0, 0); }
}
__device__ __forceinline__ void rescale_rows(f32x16* o, float f, const Ctx& c) {
    if (c.hi == 0) c.wsf[c.r32] = f;
    asm volatile("s_waitcnt lgkmcnt(0)" ::: "memory");
#pragma unroll
    for (int r = 0; r < 16; ++r) { const float fr = c.wsf[crow(r, c.hi)];
#pragma unroll
        for (int d = 0; d < 4; ++d) o[d][r] *= fr; }
}

template <int STEP>
__device__ __forceinline__ void accum_rows(f32x16* o, float f, const Ctx& c, float* scr, bf16_t* cat, size_t tok0, int g) {
    if (c.hi == 0) c.wsf[c.r32] = f;
    int lofs = c.hi * 4096 + g * 512 + c.r32;
    asm volatile("" : "+v"(lofs));
    unsigned sofs = ((unsigned)(tok0 >> 6) * 2u + (unsigned)g) * 32768u + (unsigned)c.wid * 4096u + (unsigned)c.lane * 4u;
    asm volatile("" : "+v"(sofs));
    asm volatile("s_waitcnt lgkmcnt(0)" ::: "memory");
    float* sb = scr + sofs;
    bf16_t* cb = cat + tok0 * DM + (lofs + c.hi * 4096);
    if (STEP > 0) {
        f32x4 t[16];
#pragma unroll
        for (int i4 = 0; i4 < 16; ++i4) t[i4] = *(const f32x4*)(sb + i4 * 256);
#pragma unroll
        for (int r = 0; r < 16; ++r) { const float fr = c.wsf[crow(r, c.hi)];
#pragma unroll
            for (int d0 = 0; d0 < 4; ++d0) o[d0][r] = fmaf(o[d0][r], fr, t[d0 * 4 + (r >> 2)][r & 3]); }
    } else {
#pragma unroll
        for (int r = 0; r < 16; ++r) { const float fr = c.wsf[crow(r, c.hi)];
#pragma unroll
            for (int d0 = 0; d0 < 4; ++d0) o[d0][r] *= fr; }
    }
    if (STEP < 2) {
#pragma unroll
        for (int d0 = 0; d0 < 4; ++d0)
#pragma unroll
            for (int k = 0; k < 4; ++k) *(f32x4*)(sb + (d0 * 4 + k) * 256) = (f32x4){o[d0][4 * k], o[d0][4 * k + 1], o[d0][4 * k + 2], o[d0][4 * k + 3]};
    } else {
#pragma unroll
        for (int r = 0; r < 16; ++r)
#pragma unroll
            for (int d0 = 0; d0 < 4; ++d0) { const float v = o[d0][r];
                const float vn = __int_as_float(__builtin_amdgcn_update_dpp(0, __float_as_int(v), 0xB1  , 0xf, 0xf, false));
                if ((c.r32 & 1) == 0) *(unsigned*)(cb + (r & 3) * DM + (r >> 2) * 128 + d0 * 32) = cvtpk(v, vn); }
    }
#pragma unroll
    for (int r = 0; r < 16; ++r)
#pragma unroll
        for (int d0 = 0; d0 < 4; ++d0) o[d0][r] = 0.f;
}

struct Chain { const bf16_t* Kp; const bf16_t* Vp; size_t ld; const LAS int* tl; int nt; };
template <int BR, int MODE>
__device__ __forceinline__ bool attn_pass(const Ctx& c, const bf16x8* qr, const bf16_t* Kp, const bf16_t* Vp, size_t ld, const LAS int* tl, int nt,
                                          int pos, float nslopeS, const u32x4 selw, float& m_reg, float& l_reg, f32x16* o, LAS float* impq, bool pre, int& slot, const Chain nx, int pflag = 0) {
    if (nt <= 0) return false;
    constexpr float C2 = 1.4426950408889634f * SCALE;
    if (!pre) {
        asm volatile("s_waitcnt vmcnt(0) lgkmcnt(0)" ::: "memory");
        __builtin_amdgcn_s_barrier();
        glds_tile(c, Kp, Vp, ld, tl[0], 0);
        if (nt > 1) glds_tile(c, Kp, Vp, ld, tl[1], 1);
        slot = 0; }
    for (int t = 0; t < nt; ++t) {
        if (t + 1 < nt) asm volatile("s_waitcnt vmcnt(4)" ::: "memory"); else asm volatile("s_waitcnt vmcnt(0)" ::: "memory");
        __builtin_amdgcn_s_barrier();
        if (t + 2 < nt) glds_tile(c, Kp, Vp, ld, tl[t + 2], slot == 0 ? 2 : slot - 1);
        const int krow0 = tl[t];
        const LAS char* Kimg = c.lds + slot * SLOTB + L_K; const int vbase = c.vb0 + slot * SLOTB;
        bool selected = true, need_mask;
        const int pmin = pos - (c.r32 & 7);
        if (BR == 0) need_mask = (krow0 + 63) * 16 + 31 > __builtin_amdgcn_readfirstlane(pmin);
        else if (BR == 1) { const int blk = krow0 >> 6, wsel = blk >> 5; const unsigned ww = wsel == 0 ? selw.x : (wsel == 1 ? selw.y : (wsel == 2 ? selw.z : selw.w)); selected = (ww >> (blk & 31)) & 1u;
                            need_mask = krow0 + 63 > __builtin_amdgcn_readfirstlane(pmin); }
        else need_mask = (krow0 + 63 > __builtin_amdgcn_readfirstlane(pmin)) || (krow0 < __builtin_amdgcn_readfirstlane(pmin) + 7 - (WIN - 1));
        f32x16 p0, p1;
        bias_init<BR>(p0, p1, pos, krow0, c.hi, nslopeS, selected, m_reg != -__builtin_inff() ? m_reg : 0.f);
        SBAR(); qkt_acc(p0, p1, Kimg, c.r32, c.hi, qr);
        if (need_mask) mask_only<BR>(p0, p1, pos, krow0, c.hi);
        if (MODE == 2) {
#pragma unroll
            for (int r = 0; r < 16; ++r) { p0[r] = __builtin_amdgcn_exp2f(p0[r]) * l_reg; p1[r] = __builtin_amdgcn_exp2f(p1[r]) * l_reg; }
            if (!(PROBE_DUP == 14 && pflag)) { const int c4 = (krow0 >> 2) + c.hi;
              float W[16];
#pragma unroll
              for (int k = 0; k < 4; ++k) { W[2 * k] = (p0[4 * k] + p0[4 * k + 1]) + (p0[4 * k + 2] + p0[4 * k + 3]); W[2 * k + 1] = p0[4 * k + 3];
                  W[8 + 2 * k] = (p1[4 * k] + p1[4 * k + 1]) + (p1[4 * k + 2] + p1[4 * k + 3]); W[8 + 2 * k + 1] = p1[4 * k + 3]; }
#pragma unroll
              for (int j = 0; j < 16; ++j) W[j] += __int_as_float(__builtin_amdgcn_update_dpp(0, __float_as_int(W[j]), 0x128  , 0xf, 0xf, false));
              const bool b4 = (c.r32 & 16) != 0;
              float mine[8];
#pragma unroll
              for (int j = 0; j < 8; ++j) { const float send = b4 ? W[j] : W[j + 8];
                  const float recv = __int_as_float(__builtin_amdgcn_ds_swizzle(__float_as_int(send), 0x401F  ));
                  mine[j] = (b4 ? W[j + 8] : W[j]) + recv; }
              if ((c.r32 & 8) == 0) { LAS float* ip = impq + c4 + (b4 ? 8 : 0);
                  if (c.hi == 0) { float t[8];
#pragma unroll
                      for (int j = 0; j < 8; ++j) t[j] = ip[j];
#pragma unroll
                      for (int j = 0; j < 8; ++j) ip[j] = t[j] + mine[j]; }
                  asm volatile("" ::: "memory");
                  if (c.hi != 0) { float t[8];
#pragma unroll
                      for (int j = 0; j < 8; ++j) t[j] = ip[j];
#pragma unroll
                      for (int j = 0; j < 8; ++j) ip[j] = t[j] + mine[j]; } } }
            bf16x8 pa0, pa1, pa2, pa3; PK4(p0, 0, pa0); PK4(p0, 8, pa1); PK4(p1, 0, pa2); PK4(p1, 8, pa3);
            if (!(PROBE_DUP == 15 && pflag)) pv_tile(o, vbase, pa0, pa1, pa2, pa3);
        } else {
            float al; bf16x8 pa0, pa1, pa2, pa3;
            partialSM2(p0, p1, m_reg, al);
            if (MODE == 1) { if (__any(al < 1.f)) rescale_rows(o, al, c); }
            finishSM(p0, p1, al, l_reg, pa0, pa1, pa2, pa3); SBAR();
            if (MODE == 1) pv_tile(o, vbase, pa0, pa1, pa2, pa3);
        }
        slot = slot == 2 ? 0 : slot + 1;
    }
    return false;
}

__device__ __forceinline__ void topk_select(const Ctx& c, int cur) {
    const int qi = c.lane >> 3, sub = c.lane & 7, q = c.wid * 8 + qi;
    const LAS float* row = (const LAS float*)(c.lds + L_IMP) + q * IMP_LD;
    LAS unsigned* sm = (LAS unsigned*)(c.lds + L_SELM) + q * 4;
    unsigned mw[4] = {0u, 0u, 0u, 0u};
    const int ncand = cur - 2 > 0 ? cur - 2 : 0;
    const int nforced = cur >= 2 ? 3 : cur + 1;
    const int npick = SELK - nforced;
    if (ncand <= npick) {
#pragma unroll
        for (int w = 0; w < 4; ++w) { const int lo = w * 32; int nb = cur + 1 - lo; nb = nb < 0 ? 0 : (nb > 32 ? 32 : nb); mw[w] = nb == 32 ? 0xffffffffu : ((1u << nb) - 1u); }
    } else {
        float v[16];
#pragma unroll
        for (int j = 0; j < 16; ++j) { const int n = sub * 16 + j; const float x = row[n]; v[j] = (n >= 1 && n <= cur - 2) ? x : -1.0f; }
        for (int it = 0; it < npick; ++it) {
            float bv = v[0]; int bn = sub * 16;
#pragma unroll
            for (int j = 1; j < 16; ++j) { if (v[j] > bv) { bv = v[j]; bn = sub * 16 + j; } }
#pragma unroll
            for (int o = 0; o < 3; ++o) {
                const int ctl = o == 0 ? 0xB1 : (o == 1 ? 0x4E : 0x141);
                const float ov = __int_as_float(o == 0 ? __builtin_amdgcn_update_dpp(0, __float_as_int(bv), 0xB1, 0xf, 0xf, false) : o == 1 ? __builtin_amdgcn_update_dpp(0, __float_as_int(bv), 0x4E, 0xf, 0xf, false) : __builtin_amdgcn_update_dpp(0, __float_as_int(bv), 0x141, 0xf, 0xf, false));
                const int on = o == 0 ? __builtin_amdgcn_update_dpp(0, bn, 0xB1, 0xf, 0xf, false) : o == 1 ? __builtin_amdgcn_update_dpp(0, bn, 0x4E, 0xf, 0xf, false) : __builtin_amdgcn_update_dpp(0, bn, 0x141, 0xf, 0xf, false);
                (void)ctl; const bool take = (ov > bv) | ((ov == bv) & (on < bn)); bv = take ? ov : bv; bn = take ? on : bn; }
#pragma unroll
            for (int j = 0; j < 16; ++j) if (bn == sub * 16 + j) v[j] = -2.0f;
#pragma unroll
            for (int w = 0; w < 4; ++w) if ((bn >> 5) == w) mw[w] |= 1u << (bn & 31);
        }
        mw[0] |= 1u;
#pragma unroll
        for (int w = 0; w < 4; ++w) { if ((cur >> 5) == w) mw[w] |= 1u << (cur & 31); if (cur >= 1 && ((cur - 1) >> 5) == w) mw[w] |= 1u << ((cur - 1) & 31); }
    }
    if (sub == 0) { sm[0] = mw[0]; sm[1] = mw[1]; sm[2] = mw[2]; sm[3] = mw[3]; }
}

__device__ __forceinline__ void nsa_unit(const Args& a, LAS char* lds, int b, int g, int qt, int probe = 0) {
    Ctx c; c.lds = lds; c.tid = TIDX(); c.wid = __builtin_amdgcn_readfirstlane(c.tid >> 6); c.lane = c.tid & 63; c.r32 = c.lane & 31; c.hi = c.lane >> 5;
    c.vb0 = (int)(uintptr_t)(lds + L_V) + v_rd_base(c.lane);
    c.wsf = (LAS float*)(lds + L_WS) + c.wid * 64;
#ifndef NSA_PRIO_SPLIT
#define NSA_PRIO_SPLIT 1
#endif
    if (NSA_PRIO_SPLIT) { if (c.wid & 4) __builtin_amdgcn_s_setprio(0); else __builtin_amdgcn_s_setprio(2); }
    const int hr = c.r32 >> 3, qi = c.r32 & 7, head = g * 4 + hr, q0 = qt * 64, ql = c.wid * 8 + qi, pos = q0 + ql, cur = qt;
    const bf16_t* P = (const bf16_t*)(a.ws + WS_P); const bf16_t* Pb = P + (size_t)b * SEQ * INP;
    const size_t prow = (size_t)(b * SEQ + pos) * INP;
    const float slope = exp2f(-(float)(head + 1)), nslopeS = -slope * 1.4426950408889634f;
    bf16x8 qr[8];
#pragma unroll
    for (int d0 = 0; d0 < 8; ++d0) { const u32x4 qw = *(const u32x4*)(P + prow + PC_QN + head * HD + d0 * 16 + c.hi * 8);
        constexpr float QS = SCALE * 1.4426950408889634f; u32x4 o_;
        o_.x = cvtpk(__uint_as_float(qw.x << 16) * QS, __uint_as_float(qw.x & 0xffff0000u) * QS); o_.y = cvtpk(__uint_as_float(qw.y << 16) * QS, __uint_as_float(qw.y & 0xffff0000u) * QS);
        o_.z = cvtpk(__uint_as_float(qw.z << 16) * QS, __uint_as_float(qw.z & 0xffff0000u) * QS); o_.w = cvtpk(__uint_as_float(qw.w << 16) * QS, __uint_as_float(qw.w & 0xffff0000u) * QS);
        qr[d0] = __builtin_bit_cast(bf16x8, o_); }
    bf16_t graw[3];
#pragma unroll
    for (int j = 0; j < 3; ++j) graw[j] = P[prow + PC_GN + head * 3 + j];
#define GATE(j) sigmoidf_(bf2f(graw[j]))
    LAS int* tl0 = (LAS int*)(lds + L_TL); LAS int* tl1 = tl0 + 132; LAS int* tl2 = tl1 + 132;
    LAS float* imp = (LAS float*)(lds + L_IMP);
    for (int i = c.tid; i < 64 * IMP_LD; i += NT) imp[i] = 0.f;
    const int ncmax = (q0 + 63 >= 31) ? (q0 + 63 - 31) / 16 + 1 : 0, ntc = (ncmax + 63) / 64;
    const int wlo = cur - 8 > 0 ? cur - 8 : 0, ntw = ((PROBE_DUP == 8 || PROBE_DUP >= 12) && probe) ? 0 : cur - wlo + 1;
    if (c.tid < ntc) tl0[c.tid] = (ntc - 1 - c.tid) * 64;
    if (c.tid < ntw) tl2[c.tid] = (cur - c.tid) * 64;
    asm volatile("" :: "v"(qr[0]), "v"(qr[1]), "v"(qr[2]), "v"(qr[3]), "v"(qr[4]), "v"(qr[5]), "v"(qr[6]), "v"(qr[7]));
    __syncthreads();
    f32x16 o[4];
#pragma unroll
    for (int d = 0; d < 4; ++d) o[d] = f32x16{};
    float* scr = (float*)(a.ws + WS_U1);
    const size_t tok0 = (size_t)(b * SEQ + q0 + c.wid * 8);
    u32x4 selw = {0u, 0u, 0u, 0u};
    int ring = 0; bool prew = false;
    const bf16_t* kcp = (const bf16_t*)(a.ws + WS_KC) + (size_t)b * 512 * 2 * HD + g * HD; const bf16_t* vcp = kcp + (size_t)4096 * HD;
    {
        float m = -__builtin_inff(), l = 0.f;
        const Chain none{nullptr, nullptr, 0, nullptr, 0};
        const bool pre2 = attn_pass<0, 0>(c, qr, kcp, vcp, 2 * HD, tl0, (PROBE_DUP == 13 && probe) ? 0 : ntc, pos, nslopeS, selw, m, l, o, nullptr, false, ring, Chain{kcp, vcp, (size_t)(2 * HD), tl0, ntc});
        float invl = l > 0.f ? 1.0f / l : 0.f;
        attn_pass<0, 2>(c, qr, kcp, vcp, 2 * HD, tl0, ((PROBE_DUP == 12 || PROBE_DUP == 13) && probe) ? 0 : ntc, pos, nslopeS, selw, m, invl, o, imp + ql * IMP_LD, pre2, ring, none, probe);
        accum_rows<0>(o, GATE(0), c, scr, nullptr, tok0, g);
    }
    __syncthreads();
    topk_select(c, cur);
    __syncthreads();
    {
        const LAS unsigned* smq = (const LAS unsigned*)(lds + L_SELM) + ql * 4;
        selw.x = smq[0]; selw.y = smq[1]; selw.z = smq[2]; selw.w = smq[3];
        if (c.wid == 0) { const LAS unsigned* s2 = (const LAS unsigned*)(lds + L_SELM) + c.lane * 4;
            unsigned u0 = s2[0], u1 = s2[1], u2 = s2[2], u3 = s2[3];
            u0 = wave_or(u0); u1 = wave_or(u1); u2 = wave_or(u2); u3 = wave_or(u3);
            const int c1 = __builtin_popcount(u1), c2 = __builtin_popcount(u2), c3 = __builtin_popcount(u3);
#pragma unroll
            for (int hb = 0; hb < 2; ++hb) { const int n = c.lane + 64 * hb, w = n >> 5, bit = n & 31;
                const unsigned uw = w == 0 ? u0 : (w == 1 ? u1 : (w == 2 ? u2 : u3));
                if ((uw >> bit) & 1u) { const int above = (bit == 31 ? 0 : __builtin_popcount(uw >> (bit + 1))) + (w < 3 ? c3 : 0) + (w < 2 ? c2 : 0) + (w < 1 ? c1 : 0);
                    tl1[above] = n * 64; } }
            if (c.lane == 0) tl1[128] = __builtin_popcount(u0) + c1 + c2 + c3; }
    }
    __syncthreads();
    const int nts = ((PROBE_DUP == 7 || PROBE_DUP == 8 || PROBE_DUP >= 12) && probe) ? 0 : tl1[128];
    {
        float m = -__builtin_inff(), l = 0.f;
        prew = attn_pass<1, 1>(c, qr, Pb + PC_KS + g * HD, Pb + PC_VS + g * HD, INP, tl1, nts, pos, nslopeS, selw, m, l, o, nullptr, false, ring, Chain{Pb + PC_KW + g * HD, Pb + PC_VW + g * HD, (size_t)INP, tl2, ntw});
        accum_rows<1>(o, l > 0.f ? GATE(1) / l : 0.f, c, scr, nullptr, tok0, g);
#if PROBE_DUP == 7
        { }
#endif
#if PROBE_DUP == 8
        topk_select(c, cur); __syncthreads();
#endif
    }
    {
        float m = -__builtin_inff(), l = 0.f;
        attn_pass<2, 1>(c, qr, Pb + PC_KW + g * HD, Pb + PC_VW + g * HD, INP, tl2, ntw, pos, nslopeS, selw, m, l, o, nullptr, prew, ring, Chain{nullptr, nullptr, 0, nullptr, 0});
        accum_rows<2>(o, l > 0.f ? GATE(2) / l : 0.f, c, scr, (bf16_t*)(a.ws + WS_CAT), tok0, g);
    }
    if (NSA_PRIO_SPLIT) __builtin_amdgcn_s_setprio(0);
    __syncthreads();
}
#undef GATE
#undef PK4
}

__device__ __forceinline__ void phase_nsa(const Args& a, LAS unsigned char* lds, int qidx) {
    int* qh = (int*)(a.ws + WS_CTL + CW_Q + qidx * 256);
    LAS int* ub = (LAS int*)(lds + nsa::L_END);
    const int tid = TIDX();
    const int cpre = gridDim.x == 256 ? CONV_PRE_UNITS : 0;
    const int nct = qidx == 0 ? (CONV_NCT * CONV_B - cpre) / CONV_B : 0, total = BATCH * NSA_G * 128 + nct;
    if (tid == 0) ub[0] = atomicAdd(qh, 1);
    __syncthreads();
    int t = ub[0];
    __syncthreads();
    while (t < total) {
        int nx = 0; if (tid == 0) nx = atomicAdd(qh, 1);
        if ((t & 1) && (t >> 1) < nct) conv_moe_run(a, lds, cpre + (t >> 1) * CONV_B, 1, CONV_B);
        else { const int u = t - ((t >> 1) < nct ? (t >> 1) : nct); const int qt = 127 - (u >> 3), bg = u & 7;
            nsa::nsa_unit(a, (LAS char*)lds, bg >> 1, bg & 1, qt, qidx); }
        if (tid == 0) ub[0] = nx;
        __syncthreads();
        t = ub[0];
        __syncthreads();
    }
}
namespace gla {
using nsa::v_st; using nsa::v_rd_base; using nsa::crow; using nsa::cvtpk;
constexpr int L_K = 0;
constexpr int L_QH = 16384;
constexpr int QH_LD = 272, KT_LD = 144;
constexpr int L_SEG = L_QH + 18432;
constexpr int L_AF = L_SEG + 2048;
constexpr int L_V = 40960;
constexpr int OT_LD = 260;
constexpr int L_END = L_V + 6 * 16384;

__device__ __forceinline__ void pv2(f32x16* o2, int vbase, bf16x8 pa0, bf16x8 pa1, bf16x8 pa2, bf16x8 pa3) {
#define TRRD(dst, off) asm volatile("ds_read_b64_tr_b16 %0, %1 offset:%2" : "=&v"(dst) : "v"(vbase), "i"(off) : "memory")
#define PV_RD(S, d0) do { constexpr int b_ = (d0) * 512; \
        TRRD(S[0], b_); TRRD(S[4], b_ + 2048); TRRD(S[1], b_ + 4096); TRRD(S[5], b_ + 6144); TRRD(S[2], b_ + 8192); TRRD(S[6], b_ + 10240); TRRD(S[3], b_ + 12288); TRRD(S[7], b_ + 14336); } while (0)
#define PV_MM(S, d0) do { \
        o2[d0] = __builtin_amdgcn_mfma_f32_32x32x16_bf16(pa0, (bf16x8){S[0][0], S[0][1], S[0][2], S[0][3], S[4][0], S[4][1], S[4][2], S[4][3]}, o2[d0], 0, 0, 0);   \
        o2[d0] = __builtin_amdgcn_mfma_f32_32x32x16_bf16(pa1, (bf16x8){S[1][0], S[1][1], S[1][2], S[1][3], S[5][0], S[5][1], S[5][2], S[5][3]}, o2[d0], 0, 0, 0);   \
        o2[d0] = __builtin_amdgcn_mfma_f32_32x32x16_bf16(pa2, (bf16x8){S[2][0], S[2][1], S[2][2], S[2][3], S[6][0], S[6][1], S[6][2], S[6][3]}, o2[d0], 0, 0, 0);   \
        o2[d0] = __builtin_amdgcn_mfma_f32_32x32x16_bf16(pa3, (bf16x8){S[3][0], S[3][1], S[3][2], S[3][3], S[7][0], S[7][1], S[7][2], S[7][3]}, o2[d0], 0, 0, 0); } while (0)
    s16x4 A_[8], B_[8];
    PV_RD(A_, 0); PV_RD(B_, 1);
    asm volatile("s_waitcnt lgkmcnt(8)" : "+v"(A_[0]), "+v"(A_[1]), "+v"(A_[2]), "+v"(A_[3]), "+v"(A_[4]), "+v"(A_[5]), "+v"(A_[6]), "+v"(A_[7]) :: "memory"); __builtin_amdgcn_sched_barrier(0);
    PV_MM(A_, 0); __builtin_amdgcn_sched_barrier(0);
    asm volatile("s_waitcnt lgkmcnt(0)" : "+v"(B_[0]), "+v"(B_[1]), "+v"(B_[2]), "+v"(B_[3]), "+v"(B_[4]), "+v"(B_[5]), "+v"(B_[6]), "+v"(B_[7]) :: "memory"); __builtin_amdgcn_sched_barrier(0);
    PV_MM(B_, 1);
#undef PV_MM
#undef PV_RD
#undef TRRD
}
__device__ __forceinline__ void stage_vimg(LAS char* lds, int img, const bf16_t* src, size_t ld) {
    const int tid = TIDX(), sr = tid >> 4, sc = (tid & 15) * 8;
    const bf16x8 x0 = *(const bf16x8*)(src + (size_t)sr * ld + sc), x1 = *(const bf16x8*)(src + (size_t)(sr + 32) * ld + sc);
    *(LAS bf16x8*)(lds + L_V + img * 16384 + v_st(sr, sc)) = x0; *(LAS bf16x8*)(lds + L_V + img * 16384 + v_st(32 + sr, sc)) = x1;
}
__device__ __forceinline__ void cum_decay(const Args& a, LAS char* lds, int h, float (&bcum)[16], float& tot, const float (&w)[16], const float bgv) {
    const int tid = TIDX(), d = tid & 127, seg = tid >> 7;
    const LAS float* af = (const LAS float*)(lds + L_AF); LAS float* segt = (LAS float*)(lds + L_SEG);
    float run = 0.f;
#pragma unroll
    for (int i = 0; i < 16; ++i) { const int t = seg * 16 + i; float z = bgv;
#pragma unroll
        for (int j = 0; j < 16; j += 4) { const f32x4 av = *(const LAS f32x4*)(af + t * 16 + j); z = fmaf(av[0], w[j], z); z = fmaf(av[1], w[j + 1], z); z = fmaf(av[2], w[j + 2], z); z = fmaf(av[3], w[j + 3], z); }
        const float ls = fminf(z, 0.f) - __logf(1.0f + __expf(-fabsf(z)));
        run += ls * (1.0f / 16.0f); bcum[i] = run; }
    segt[seg * 128 + d] = run;
    __syncthreads();
    const float s0 = segt[d], s1 = segt[128 + d], s2 = segt[256 + d], s3 = segt[384 + d];
    const float off = seg == 0 ? 0.f : (seg == 1 ? s0 : (seg == 2 ? s0 + s1 : (s0 + s1) + s2));
    tot = ((s0 + s1) + s2) + s3;
#pragma unroll
    for (int i = 0; i < 16; ++i) bcum[i] += off;
}
__device__ __forceinline__ void load_atile(const Args& a, LAS char* lds, int row0) {
    const bf16_t* P = (const bf16_t*)(a.ws + WS_P); LAS float* af = (LAS float*)(lds + L_AF);
    for (int e = TIDX(); e < 1024; e += NT) { const int t = e >> 4, j = e & 15; af[e] = bf2f(P[(size_t)(row0 + t) * INP + PC_AG + j]); }
}

constexpr int A_KT = 0, A_SEG = 18432, A_AF = 19456, A_V = 23552, A_HALF = 57344;
__device__ __forceinline__ void phase_a(const Args& a, LAS char* lds0) {
    const int tid = TIDX(), half = __builtin_amdgcn_readfirstlane(tid >> 8), ht = tid & 255, wv = __builtin_amdgcn_readfirstlane((tid >> 6) & 3), lane = tid & 63, r32 = lane & 31, hi = lane >> 5;
    const int d = ht & 127, seg = ht >> 7;
    LAS char* lds = lds0 + half * A_HALF;
    const bf16_t* P = (const bf16_t*)(a.ws + WS_P);
    bf16_t* sloc = (bf16_t*)(a.ws + WS_SLOC); float* dec = (float*)(a.ws + WS_DEC);
    const float* wg = a.in[I_GWG];
    for (int up = blockIdx.x; up < 1024; up += gridDim.x) {
        const int u = up * 2 + half, bh = u >> 7, ci = u & 127, b = bh >> 2, h = bh & 3, row0 = b * SEQ + ci * 64;
        { LAS float* af = (LAS float*)(lds + A_AF); for (int e = ht; e < 1024; e += 256) { const int t = e >> 4, j = e & 15; af[e] = bf2f(P[(size_t)(row0 + t) * INP + PC_AG + j]); } }
        { const int sr = ht >> 4, sc = (ht & 15) * 8;
#pragma unroll
          for (int img = 0; img < 2; ++img)
#pragma unroll
              for (int q = 0; q < 4; ++q) { const int r = sr + 16 * q; const bf16x8 x = *(const bf16x8*)(P + (size_t)(row0 + r) * INP + PC_VG + h * 256 + img * 128 + sc);
                  *(LAS bf16x8*)(lds + A_V + img * 16384 + v_st(r, sc)) = x; } }
        bf16_t kraw[32];
#pragma unroll
        for (int i = 0; i < 32; ++i) kraw[i] = P[(size_t)(row0 + seg * 32 + i) * INP + PC_KG + h * 128 + d];
        float w[16]; const float bgv = a.in[I_GBG][h * 128 + d];
#pragma unroll
        for (int j = 0; j < 16; ++j) w[j] = wg[j * 512 + h * 128 + d];
        __syncthreads();
        float bcum[32], tot;
        { const LAS float* af = (const LAS float*)(lds + A_AF); LAS float* segt = (LAS float*)(lds + A_SEG);
          float run = 0.f;
#pragma unroll
          for (int i = 0; i < 32; ++i) { const int t = seg * 32 + i; float z = bgv;
#pragma unroll
              for (int j = 0; j < 16; j += 4) { const f32x4 av = *(const LAS f32x4*)(af + t * 16 + j); z = fmaf(av[0], w[j], z); z = fmaf(av[1], w[j + 1], z); z = fmaf(av[2], w[j + 2], z); z = fmaf(av[3], w[j + 3], z); }
              const float ls = fminf(z, 0.f) - __logf(1.0f + __expf(-fabsf(z)));
              run += ls * (1.0f / 16.0f); bcum[i] = run; }
          segt[seg * 128 + d] = run;
          __syncthreads();
          const float s0 = segt[d], s1 = segt[128 + d];
          tot = s0 + s1;
          if (seg == 1) {
#pragma unroll
              for (int i = 0; i < 32; ++i) bcum[i] += s0; } }
#pragma unroll
        for (int i = 0; i < 32; i += 2) { const int t = seg * 32 + i;
            *(LAS unsigned*)(lds + A_KT + d * KT_LD + t * 2) = cvt_pk_bf16(bf2f(kraw[i]) * __expf(tot - bcum[i]), bf2f(kraw[i + 1]) * __expf(tot - bcum[i + 1])); }
        if (seg == 0) dec[(size_t)u * 128 + d] = __expf(tot);
        __syncthreads();
        {
            const int db = wv;
            const LAS char* kr = lds + A_KT + (32 * db + r32) * KT_LD + hi * 16;
            const bf16x8 pa0 = *(const LAS bf16x8*)(kr), pa1 = *(const LAS bf16x8*)(kr + 32), pa2 = *(const LAS bf16x8*)(kr + 64), pa3 = *(const LAS bf16x8*)(kr + 96);
            f32x16 o[2][4];
#pragma unroll
            for (int vh = 0; vh < 2; ++vh) {
#pragma unroll
                for (int q = 0; q < 4; ++q) o[vh][q] = f32x16{};
                const int vb = (int)(uintptr_t)(lds + A_V) + vh * 16384 + v_rd_base(lane);
                pv2(o[vh], vb, pa0, pa1, pa2, pa3); pv2(o[vh] + 2, vb + 1024, pa0, pa1, pa2, pa3); }
            __syncthreads();
            LAS char* stg = lds + A_V + wv * 8192;
#pragma unroll
            for (int vh = 0; vh < 2; ++vh) {
#pragma unroll
                for (int r = 0; r < 16; ++r)
#pragma unroll
                    for (int d0 = 0; d0 < 4; ++d0) { const float v = o[vh][d0][r];
                        const float vn = __int_as_float(__builtin_amdgcn_update_dpp(0, __float_as_int(v), 0xB1, 0xf, 0xf, false));
                        if ((r32 & 1) == 0) *(LAS unsigned*)(stg + crow(r, hi) * 256 + (d0 * 32 + r32) * 2) = cvt_pk_bf16(v, vn); }
                asm volatile("s_waitcnt lgkmcnt(0)" ::: "memory");
                bf16_t* sp = sloc + ((size_t)u * 128 + 32 * db) * 256 + 128 * vh;
#pragma unroll
                for (int it = 0; it < 8; ++it) { const int id = it * 64 + lane, row = id >> 4, c16 = id & 15;
                    const u32x4 w = *(const LAS u32x4*)(stg + row * 256 + c16 * 16);
                    *(u32x4*)(sp + (size_t)row * 256 + c16 * 8) = w; }
                asm volatile("s_waitcnt lgkmcnt(0)" ::: "memory"); }
        }
        __syncthreads();
    }
}

__device__ __forceinline__ void phase_b(const Args& a) {
    const bf16_t* sloc = (const bf16_t*)(a.ws + WS_SLOC); const float* dec = (const float*)(a.ws + WS_DEC); bf16_t* st = (bf16_t*)(a.ws + WS_STATE);
    for (int gi = blockIdx.x * NT + TIDX(); gi < 16 * 128 * 64; gi += gridDim.x * NT) {
        const int bh = gi >> 13, d = (gi >> 6) & 127, v4 = (gi & 63) * 4;
        f32x4 S = {0.f, 0.f, 0.f, 0.f};
        const size_t base = ((size_t)bh * 128 * 128 + d) * 256 + v4;
        for (int c0 = 0; c0 < 128; c0 += 8) {
            u32x2 sw[8]; float dc[8];
#pragma unroll
            for (int k = 0; k < 8; ++k) { sw[k] = *(const u32x2*)(sloc + base + (size_t)(c0 + k) * 128 * 256); dc[k] = dec[((size_t)bh * 128 + c0 + k) * 128 + d]; }
#pragma unroll
            for (int k = 0; k < 8; ++k) { const f32x4 sl = {__uint_as_float(sw[k].x << 16), __uint_as_float(sw[k].x & 0xffff0000u), __uint_as_float(sw[k].y << 16), __uint_as_float(sw[k].y & 0xffff0000u)};
                u32x2 w; w.x = cvtpk(S[0], S[1]); w.y = cvtpk(S[2], S[3]); *(u32x2*)(st + base + (size_t)(c0 + k) * 128 * 256) = w;
                S = S * dc[k] + sl; } }
    }
}

__device__ __forceinline__ void phase_c(const Args& a, LAS char* lds) {
    const int tid = TIDX(), wid = __builtin_amdgcn_readfirstlane(tid >> 6), lane = tid & 63, r32 = lane & 31, hi = lane >> 5, d = tid & 127, seg = tid >> 7;
    const bf16_t* P = (const bf16_t*)(a.ws + WS_P); const bf16_t* st = (const bf16_t*)(a.ws + WS_STATE); bf16_t* cat = (bf16_t*)(a.ws + WS_CAT);
    const float* nw = a.in[I_GNW];
    const f32x4 nwv = *(const f32x4*)(nw + lane * 4);
    for (int u = blockIdx.x; u < 2048; u += gridDim.x) {
        const int bh = u >> 7, ci = u & 127, b = bh >> 2, h = bh & 3, row0 = b * SEQ + ci * 64;
        const bf16_t* su = st + (size_t)u * 128 * 256;
        bf16x8 im[6][2];
        { const int sr = tid >> 4, sc = (tid & 15) * 8;
          const bf16_t* vsrc = P + (size_t)row0 * INP + PC_VG + h * 256;
#pragma unroll
          for (int q = 0; q < 2; ++q) { im[0][q] = *(const bf16x8*)(vsrc + (size_t)(sr + 32 * q) * INP + sc); im[1][q] = *(const bf16x8*)(vsrc + (size_t)(sr + 32 * q) * INP + 128 + sc);
              im[2][q] = *(const bf16x8*)(su + (size_t)(sr + 32 * q) * 256 + sc); im[3][q] = *(const bf16x8*)(su + (size_t)(sr + 32 * q) * 256 + 128 + sc);
              im[4][q] = *(const bf16x8*)(su + (size_t)(64 + sr + 32 * q) * 256 + sc); im[5][q] = *(const bf16x8*)(su + (size_t)(64 + sr + 32 * q) * 256 + 128 + sc); } }
        bf16_t araw[2];
#pragma unroll
        for (int q = 0; q < 2; ++q) { const int e = tid + q * NT; araw[q] = P[(size_t)(row0 + (e >> 4)) * INP + PC_AG + (e & 15)]; }
        bf16_t qraw[16], kraw[16];
#pragma unroll
        for (int i = 0; i < 16; ++i) { const size_t ro = (size_t)(row0 + seg * 16 + i) * INP + h * 128 + d; qraw[i] = P[ro + PC_QG]; kraw[i] = P[ro + PC_KG]; }
        float wgc[16]; const float bgv = a.in[I_GBG][h * 128 + d];
#pragma unroll
        for (int j = 0; j < 16; ++j) wgc[j] = a.in[I_GWG][j * 512 + h * 128 + d];
        { const int sr = tid >> 4, sc = (tid & 15) * 8;
#pragma unroll
          for (int im_ = 0; im_ < 6; ++im_)
#pragma unroll
              for (int q = 0; q < 2; ++q) *(LAS bf16x8*)(lds + L_V + im_ * 16384 + v_st(sr + 32 * q, sc)) = im[im_][q];
          LAS float* af = (LAS float*)(lds + L_AF);
#pragma unroll
          for (int q = 0; q < 2; ++q) af[tid + q * NT] = bf2f(araw[q]); }
        __syncthreads();
        float bcum[16], tot;
        cum_decay(a, lds, h, bcum, tot, wgc, bgv);
#pragma unroll
        for (int i = 0; i < 16; ++i) { const int t = seg * 16 + i;
            const float qv = bf2f(qraw[i]) * 0.08838834764831845f, kv = bf2f(kraw[i]);
            const float qh = qv * __expf(bcum[i]), kh = kv * __expf(-bcum[i]);
            const float qn = __int_as_float(__builtin_amdgcn_update_dpp(0, __float_as_int(qh), 0xB1, 0xf, 0xf, false)), kn = __int_as_float(__builtin_amdgcn_update_dpp(0, __float_as_int(kh), 0xB1, 0xf, 0xf, false));
            if ((d & 1) == 0) { *(LAS unsigned*)(lds + L_QH + t * QH_LD + d * 2) = cvt_pk_bf16(qh, qn);
                *(LAS unsigned*)(lds + L_K + t * 256 + ((d * 2) ^ ((t & 7) << 4))) = cvt_pk_bf16(kh, kn); } }
        __syncthreads();
        const int rb = wid & 1, cq = wid >> 1, ch = cq >> 1, d0b = (cq & 1) * 2;
        u32x2 rg[8];
#pragma unroll
        for (int i = 0; i < 8; ++i) rg[i] = *(const u32x2*)(P + (size_t)(row0 + wid * 8 + i) * INP + PC_RG + h * 256 + lane * 4);
        f32x16 o2[2]; o2[0] = f32x16{}; o2[1] = f32x16{};
        {
            bf16x8 qr[8];
#pragma unroll
            for (int d0 = 0; d0 < 8; ++d0) qr[d0] = *(const LAS bf16x8*)(lds + L_QH + (32 * rb + r32) * QH_LD + (16 * d0 + 8 * hi) * 2);
            f32x16 p0, p1;
            nsa::qkt(p0, p1, (const LAS char*)(lds + L_K), r32, hi, qr);
            const int t = 32 * rb + r32;
#pragma unroll
            for (int r = 0; r < 16; ++r) { const int s = crow(r, hi); p0[r] = (s <= t) ? p0[r] : 0.f; p1[r] = (s + 32 <= t) ? p1[r] : 0.f; }
            bf16x8 pa0, pa1, pa2, pa3;
#define PK4(P_, B_, OUT) do { unsigned a0 = cvtpk(P_[B_+0], P_[B_+1]), a1 = cvtpk(P_[B_+2], P_[B_+3]); unsigned b0 = cvtpk(P_[B_+4], P_[B_+5]), b1 = cvtpk(P_[B_+6], P_[B_+7]); \
        auto r0 = __builtin_amdgcn_permlane32_swap(a0, b0, false, false); auto r1 = __builtin_amdgcn_permlane32_swap(a1, b1, false, false); \
        u32x4 w_ = {r0[0], r1[0], r0[1], r1[1]}; OUT = *reinterpret_cast<bf16x8*>(&w_); } while (0)
            PK4(p0, 0, pa0); PK4(p0, 8, pa1); PK4(p1, 0, pa2); PK4(p1, 8, pa3);
#undef PK4
            const int vb = (int)(uintptr_t)(lds + L_V) + v_rd_base(lane) + d0b * 512;
            pv2(o2, vb + ch * 16384, pa0, pa1, pa2, pa3);
            pv2(o2, vb + (2 + ch) * 16384, qr[0], qr[1], qr[2], qr[3]);
            pv2(o2, vb + (4 + ch) * 16384, qr[4], qr[5], qr[6], qr[7]);
        }
        __syncthreads();
        { LAS float* ot = (LAS float*)(lds + L_V);
#pragma unroll
          for (int r = 0; r < 16; ++r)
#pragma unroll
              for (int dd = 0; dd < 2; ++dd) ot[(32 * rb + crow(r, hi)) * OT_LD + 128 * ch + 32 * (d0b + dd) + r32] = o2[dd][r]; }
        __syncthreads();
        { const LAS float* ot = (const LAS float*)(lds + L_V);
          f32x4 ovs[8]; float ssq[8];
#pragma unroll
          for (int i = 0; i < 8; ++i) { ovs[i] = *(const LAS f32x4*)(ot + (wid * 8 + i) * OT_LD + lane * 4); ssq[i] = ovs[i][0] * ovs[i][0] + ovs[i][1] * ovs[i][1] + ovs[i][2] * ovs[i][2] + ovs[i][3] * ovs[i][3]; }
#pragma unroll
          for (int i = 0; i < 8; ++i) ssq[i] = wave_sum(ssq[i]);
#pragma unroll
          for (int i = 0; i < 8; ++i) { const int t = wid * 8 + i; const f32x4 ov = ovs[i];
              const float rs = rsqrtf(ssq[i] * (1.0f / 256.0f) + RMS_EPS);
              const u32x2 rr = rg[i];
              const float r0 = __uint_as_float(rr.x << 16), r1 = __uint_as_float(rr.x & 0xffff0000u), r2 = __uint_as_float(rr.y << 16), r3 = __uint_as_float(rr.y & 0xffff0000u);
              u32x2 w; w.x = cvtpk(ov[0] * rs * nwv[0] * (r0 / (1.0f + __expf(-r0))), ov[1] * rs * nwv[1] * (r1 / (1.0f + __expf(-r1))));
              w.y = cvtpk(ov[2] * rs * nwv[2] * (r2 / (1.0f + __expf(-r2))), ov[3] * rs * nwv[3] * (r3 / (1.0f + __expf(-r3))));
              *(u32x2*)(cat + (size_t)(row0 + t) * DM + 1024 + h * 256 + lane * 4) = w; } }
        __syncthreads();
    }
}
}
__device__ __forceinline__ void phase_gemm_in(const Args& a, LAS unsigned char* lds, int G, int c) {
    if (IN_BF16_TILES) { pg8::Gemm g{a.ws + WS_H, a.ws + WS_WTIN, DM * 2 / 128, (size_t)DM * 2};
      pg8::StaticOrder S; S.init(NTOK, INP, G, c, IN_FP8_TILES ? IN_BF16_TILES : 0u);
      pg8::EpiBf16Plain E{(bf16_t*)(a.ws + WS_P), INP, nullptr, 0, 1.0f};
      pg8::AMapPlain AM{(size_t)DM * 2};
      pg8::gemm_phase<0>(lds, g, S, E, AM); }
    if (IN_FP8_TILES) { pg8::Gemm g{a.ws + WS_H8, a.ws + WS_WTIN8, DM / 128, (size_t)DM};
      pg8::StaticOrder S; S.init(NTOK, INP, G, c, IN_BF16_TILES ? IN_FP8_TILES : 0u);
      pg8::EpiBf16Plain E{(bf16_t*)(a.ws + WS_P), INP, nullptr, 0, 1.0f / WSCALE};
      pg8::AMapPlain AM{(size_t)DM};
      pg8::gemm_phase<1>(lds, g, S, E, AM); }
}
__device__ __forceinline__ void phase_gemm_out(const Args& a, LAS unsigned char* lds) {
    pg8::Gemm g{a.ws + WS_CAT, a.ws + WS_WTOUT, DM * 2 / 128, (size_t)DM * 2};
    pg8::StaticOrder S; S.init(NTOK, DM, gridDim.x, blockIdx.x);
    pg8::EpiGate E{(bf16_t*)(a.ws + WS_U1) + 2048, 4096, (const float*)(a.ws + WS_MOD) + 2 * DM};
    pg8::AMapPlain AM{(size_t)DM * 2};
    pg8::gemm_phase<0>(lds, g, S, E, AM);
}
__device__ __forceinline__ void phase_moe1(const Args& a, LAS unsigned char* lds) {
    LAS int* tile_e = (LAS int*)(lds + LDS_MISC); LAS int* startp = (LAS int*)(lds + LDS_MISC + 4096); LAS unsigned short* tok = (LAS unsigned short*)(lds + LDS_MISC + 8192);
    const int ntile = moe_meta(a, tile_e, startp);
    pg8::MoeOrder S{tile_e, ntile, 16, (int)gridDim.x, (int)blockIdx.x, (size_t)4096 * DM};
    { const int* st = (const int*)(a.ws + WS_STOK); const int t8 = TIDX();
      int nu = 0; { int pm_, pn_; while (nu < 46 && S.map(nu, pm_, pn_)) ++nu; }
      if (t8 < 256) {
#pragma unroll 1
          for (int i0 = 0; i0 < nu; i0 += 12) {
              int v4[12];
#pragma unroll
              for (int k = 0; k < 12; ++k) { const int i = i0 + k < nu ? i0 + k : nu - 1; int pm_, pn_; S.map(i, pm_, pn_); v4[k] = st[pm_ * 256 + t8]; }
#pragma unroll
              for (int k = 0; k < 12; ++k) if (i0 + k < nu) tok[(i0 + k) * 256 + t8] = (unsigned short)v4[k]; } } }
    asm volatile("" ::: "memory");
    __syncthreads();
    pg8::Gemm g{a.ws + WS_H, a.ws + WS_WTGU, DM / 128, (size_t)DM};
    pg8::EpiSwiglu E{a.ws + WS_ACT, a.in[I_BGU], 1.0f / WSCALE};
    pg8::AMapGather AM{(size_t)DM, tok};
    pg8::gemm_phase<1>(lds, g, S, E, AM);
}
__device__ __forceinline__ void phase_moe2(const Args& a, LAS unsigned char* lds) {
    LAS int* tile_e = (LAS int*)(lds + LDS_MISC); LAS int* startp = (LAS int*)(lds + LDS_MISC + 4096);
    const int ntile = moe_meta(a, tile_e, startp);
    pg8::Gemm g{a.ws + WS_ACT, a.ws + WS_WTDN, DFF / 128, (size_t)DFF};
    pg8::MoeOrder S{tile_e, ntile, 8, (int)gridDim.x, (int)blockIdx.x, (size_t)DM * DFF};
    pg8::EpiBf16Plain E{(bf16_t*)(a.ws + WS_XBUF), DM, a.in[I_BDN], DM, 1.0f / WSCALE};
    pg8::AMapPlain AM{(size_t)DFF};
    pg8::gemm_phase<1>(lds, g, S, E, AM);
}

__device__ __forceinline__ float gelu_tanh_f(float x) { const float u = 0.7978845608028654f * (x + 0.044715f * x * x * x); const float e = __expf(2.0f * u); const float th = 1.0f - 2.0f / (e + 1.0f); return 0.5f * x * (1.0f + th); }
__device__ __forceinline__ void phase_pew1(const Args& a, LAS unsigned char* lds) {
    const int tid = TIDX(), j = tid & 255, kh = tid >> 8;
    LAS float* red = (LAS float*)lds; float* part = (float*)(a.ws + WS_CB);
    for (int u = blockIdx.x; u < 32; u += gridDim.x) { const int kv = u >> 4, kr = u & 15;
        const float* pe = a.in[kv ? I_PEV : I_PEK]; const float* w1 = a.in[kv ? I_W1V : I_W1K];
        float acc = 0.f; const int k0 = kr * 256 + kh * 128;
#pragma unroll 8
        for (int k = 0; k < 128; ++k) acc = fmaf(pe[k0 + k], w1[(size_t)(k0 + k) * CMPH + j], acc);
        if (kh == 1) red[j] = acc;
        __syncthreads();
        if (kh == 0) part[(kv * 16 + kr) * 256 + j] = acc + red[j];
        __syncthreads(); }
}
__device__ __forceinline__ void phase_cmp_gemm(const Args& a, LAS unsigned char* lds) {
    pg8::Gemm g{a.ws + WS_P, a.ws + WS_W1T, 8, (size_t)4096 * 2};
    pg8::CmpOrder S{(int)gridDim.x, (int)blockIdx.x};
    pg8::EpiF32Plain E{(float*)(a.ws + WS_SLAB), CMPH, (size_t)4096 * CMPH};
    pg8::AMapCmp AM;
    pg8::gemm_phase<0>(lds, g, S, E, AM);
}
__device__ __forceinline__ void phase_cmp_fin(const Args& a, LAS unsigned char* lds) {
    const int tid = TIDX(), dcol = tid & 127, jq = tid >> 7;
    LAS float* bias = (LAS float*)lds;
    LAS float* hid = (LAS float*)(lds + 2048);
    LAS float* part = (LAS float*)(lds + 2048 + 4096);
    const float* pp = (const float*)(a.ws + WS_CB); const float* slab = (const float*)(a.ws + WS_SLAB); bf16_t* kc = (bf16_t*)(a.ws + WS_KC);
    { const int kv = tid >> 8, j = tid & 255; float s = a.in[kv ? I_B1V : I_B1K][j];
      for (int r = 0; r < 16; ++r) s += pp[(kv * 16 + r) * 256 + j];
      bias[tid] = s; }
    __syncthreads();
    int kvl = -1; float w2r[64];
    for (int grp = blockIdx.x; grp < 2048; grp += gridDim.x) {
        const int kv = grp >> 10, m0 = (grp & 1023) * 4;
        if (kv != kvl) { const float* w2 = a.in[kv ? I_W2V : I_W2K];
#pragma unroll
            for (int i = 0; i < 64; ++i) w2r[i] = w2[(jq * 64 + i) * HD + dcol];
            kvl = kv; }
        { const int j = tid & 255, r2 = tid >> 8;
#pragma unroll
          for (int rr = 0; rr < 2; ++rr) { const int m = m0 + r2 + 2 * rr; float s = bias[kv * 256 + j];
#pragma unroll
              for (int ks = 0; ks < 8; ++ks) s += slab[((size_t)(kv * 8 + ks) * 4096 + m) * CMPH + j];
              hid[(r2 + 2 * rr) * 256 + j] = gelu_tanh_f(s); } }
        __syncthreads();
#pragma unroll
        for (int r = 0; r < 4; ++r) { float p = 0.f;
#pragma unroll
            for (int i = 0; i < 64; i += 4) { const f32x4 hv = *(const LAS f32x4*)(hid + r * 256 + jq * 64 + i);
                p = fmaf(hv[0], w2r[i], p); p = fmaf(hv[1], w2r[i + 1], p); p = fmaf(hv[2], w2r[i + 2], p); p = fmaf(hv[3], w2r[i + 3], p); }
            part[(r * 4 + jq) * 128 + dcol] = p; }
        __syncthreads();
        { const int r = tid >> 7, m = m0 + r, c = (m >> 1) & 511;
          const float v = ((part[(r * 4 + 0) * 128 + dcol] + part[(r * 4 + 1) * 128 + dcol]) + part[(r * 4 + 2) * 128 + dcol]) + part[(r * 4 + 3) * 128 + dcol];
          kc[((size_t)kv * 4096 + m) * HD + dcol] = c >= NCMP ? (bf16_t)0 : f2bf(v); }
        __syncthreads();
    }
}

#ifndef NGEMM
#define NGEMM 208
#endif
#ifndef PROBE_DUP
#define PROBE_DUP -1
#endif
#define RUN_PHASE(p, call) do { if (a.ph_lo <= (p) && (p) < a.ph_hi) { call; if ((p) + 1 < a.ph_hi) xcd_barrier(bar); } } while (0)
__global__ __launch_bounds__(512, 2) void mk_fwd(Args a) {
    extern __shared__ __attribute__((aligned(16))) unsigned char smem[];
    LAS unsigned char* lds = (LAS unsigned char*)smem;
    volatile LAS unsigned* xbw = (volatile LAS unsigned*)(lds + LDS_BYTES - 16);
    if (threadIdx.x == 0) { xbw[0] = 0u; xbw[1] = 0u; xbw[2] = 0u; xbw[3] = 0u; }
    __syncthreads();
    XcdBarrier bar = xcd_barrier_post((unsigned*)(a.ws + WS_CTL + CW_BAR + (size_t)a.bar_id * 16384), xbw);
    RUN_PHASE(0, (phase_mod(a, lds), phase_pew1(a, lds), phase_conv_small(a, lds), (PROBE_DUP == 30 ? (phase_mod(a, lds), phase_pew1(a, lds), phase_conv_small(a, lds)) : (void)0), phase_conv_moe(a, lds, blockIdx.x, gridDim.x), (PROBE_DUP == 60 ? phase_conv_moe(a, lds, blockIdx.x, gridDim.x) : (void)0)));
    RUN_PHASE(1, (phase_h1(a), (PROBE_DUP == 31 ? phase_h1(a) : (void)0)));
    RUN_PHASE(2, (phase_gemm_in(a, lds, gridDim.x, blockIdx.x), ((gridDim.x == 256 && blockIdx.x >= 128) ? conv_moe_run(a, lds, ((int)blockIdx.x - 128) * CONV_PRE, 1, CONV_PRE) : (void)0)));
    RUN_PHASE(3, (phase_cmp_gemm(a, lds), gla::phase_a(a, (LAS char*)lds), (PROBE_DUP == 33 ? (phase_cmp_gemm(a, lds), gla::phase_a(a, (LAS char*)lds)) : (void)0), (PROBE_DUP == 50 ? phase_cmp_gemm(a, lds) : (void)0), (PROBE_DUP == 51 ? gla::phase_a(a, (LAS char*)lds) : (void)0)));
    RUN_PHASE(4, (phase_cmp_fin(a, lds), gla::phase_b(a), (PROBE_DUP == 34 ? (phase_cmp_fin(a, lds), gla::phase_b(a)) : (void)0), (PROBE_DUP == 52 ? phase_cmp_fin(a, lds) : (void)0), (PROBE_DUP == 53 ? gla::phase_b(a) : (void)0)));
    RUN_PHASE(5, (((PROBE_DUP == 7 || PROBE_DUP == 8 || (PROBE_DUP >= 12 && PROBE_DUP <= 15)) ? phase_nsa(a, lds, 1) : (void)0), phase_nsa(a, lds, 0), (PROBE_DUP == 5 ? phase_nsa(a, lds, 1) : (void)0), gla::phase_c(a, (LAS char*)lds), (PROBE_DUP == 6 ? gla::phase_c(a, (LAS char*)lds) : (void)0)));
    RUN_PHASE(6, (phase_gemm_out(a, lds), (PROBE_DUP == 36 ? phase_gemm_out(a, lds) : (void)0)));
    RUN_PHASE(7, ((PROBE_DUP == 37 ? phase_ln1_router<true>(a, lds) : (void)0), phase_ln1_router<false>(a, lds)));
#if PROBE_DUP == 20
    for (int pb = 0; pb < 10; ++pb) xcd_barrier(bar);
#endif
    RUN_PHASE(8, phase_dispatch(a, lds));
    RUN_PHASE(9, (phase_moe1(a, lds), (PROBE_DUP == 9 ? phase_moe1(a, lds) : (void)0)));
    RUN_PHASE(10, (phase_moe2(a, lds), (PROBE_DUP == 10 ? phase_moe2(a, lds) : (void)0)));
    RUN_PHASE(11, (phase_combine_ln2(a, lds), (PROBE_DUP == 41 ? phase_combine_ln2(a, lds) : (void)0)));
}

extern "C" void kernel_launch(void* const* d_in, const int* in_sizes, int n_in, void* d_out, int out_size, void* d_ws, size_t ws_size, hipStream_t stream) {
    static int grid = 0;
    if (grid == 0) {
        if (n_in != 27 || out_size != NTOK * DM || ws_size < WS_END) { fprintf(stderr, "kernel_launch: unexpected shapes (n_in %d out %d ws %zu need %zu)\n", n_in, out_size, ws_size, (size_t)WS_END); grid = -1; return; }
        int dev = 0, cus = 0, per_cu = 0;
        if (hipGetDevice(&dev) != hipSuccess || hipDeviceGetAttribute(&cus, hipDeviceAttributeMultiprocessorCount, dev) != hipSuccess) { grid = -1; return; }
        if (hipFuncSetAttribute((const void*)mk_fwd, hipFuncAttributeMaxDynamicSharedMemorySize, LDS_BYTES) != hipSuccess) { fprintf(stderr, "kernel_launch: hipFuncSetAttribute failed\n"); grid = -1; return; }
        if (hipOccupancyMaxActiveBlocksPerMultiprocessor(&per_cu, (const void*)mk_fwd, NT, LDS_BYTES) != hipSuccess || per_cu < 1) fprintf(stderr, "kernel_launch: occupancy query says %d\n", per_cu);
        (void)hipGetLastError();
        grid = cus;
    }
    if (grid < 0) return;
    (void)hipMemsetAsync((char*)d_ws + WS_CTL, 0, CTL_BYTES, stream);
    Args a{};
    for (int i = 0; i < 27; ++i) a.in[i] = (const float*)d_in[i];
    a.out = (float*)d_out; a.ws = (unsigned char*)d_ws;
    auto run = [&](int lo, int hi, int bar) { a.ph_lo = lo; a.ph_hi = hi; a.bar_id = bar; hipLaunchKernelGGL(mk_fwd, dim3(grid), dim3(NT), LDS_BYTES, stream, a); };
    run(0, 12, 0);
}
```
